# Optimizing an MI355X kernel written in HIP

```python
import math
import jax, jax.numpy as jnp
from jax import lax
import numpy as np

D_MODEL = 1024
BATCH = 4
SEQ = 8192
DEPTH = 1

HEAD_DIM = 64
V_DIM = 2 * HEAD_DIM
N_HEADS = D_MODEL // V_DIM
D_QK = 2 * N_HEADS * HEAD_DIM
D_V = N_HEADS * V_DIM
D_CONV = D_MODEL
CONV_WIDTH = 31
D_FF = 4 * D_MODEL
N_BRANCH = 2
N_MOD = 6
ROPE_THETA = 10000.0
Q_BLOCK = 128
EPS = 1e-6
D_IN = 2 * D_CONV + 2 * D_QK + D_V + N_BRANCH * D_MODEL

kernel_name = "hybrid_conformer_diffattn_block"


def rms_norm(x, g):
    xf = x.astype(jnp.float32)
    y = xf * lax.rsqrt(jnp.mean(xf * xf, axis=-1, keepdims=True) + EPS)
    return (y * g.astype(jnp.float32)).astype(x.dtype)


def layer_norm(x, g, b):
    xf = x.astype(jnp.float32)
    mu = jnp.mean(xf, axis=-1, keepdims=True)
    xc = xf - mu
    y = xc * lax.rsqrt(jnp.mean(xc * xc, axis=-1, keepdims=True) + EPS)
    return (y * g.astype(jnp.float32) + b.astype(jnp.float32)).astype(x.dtype)


def rope(x, pos):
    half = HEAD_DIM // 2
    inv_freq = ROPE_THETA ** (-jnp.arange(0, HEAD_DIM, 2, dtype=jnp.float32) / HEAD_DIM)
    ang = pos.astype(jnp.float32)[:, None] * inv_freq[None, :]
    cos = jnp.cos(ang)[None, :, None, :]
    sin = jnp.sin(ang)[None, :, None, :]
    xf = x.astype(jnp.float32)
    x1, x2 = xf[..., :half], xf[..., half:]
    return jnp.concatenate([x1 * cos - x2 * sin, x2 * cos + x1 * sin], axis=-1).astype(x.dtype)


def lambda_init(layer_idx):
    return 0.8 - 0.6 * math.exp(-0.3 * (layer_idx - 1))


def causal_diff_attention(q1, q2, k1, k2, v, lam):
    B, T, H, Dh = q1.shape
    nb = T // Q_BLOCK
    scale = 1.0 / math.sqrt(HEAD_DIM)
    kpos = jnp.arange(T)

    def to_blocks(q):
        return q.reshape(B, nb, Q_BLOCK, H, Dh).transpose(1, 0, 2, 3, 4)

    def one_block(args):
        i, qb1, qb2 = args
        qpos = i * Q_BLOCK + jnp.arange(Q_BLOCK)
        mask = kpos[None, :] <= qpos[:, None]

        def probs(qb, k):
            s = jnp.einsum('bqhd,bkhd->bhqk', qb, k, preferred_element_type=jnp.float32) * scale
            s = jnp.where(mask[None, None], s, -jnp.inf)
            return jax.nn.softmax(s, axis=-1)

        a = probs(qb1, k1) - lam * probs(qb2, k2)
        return jnp.einsum('bhqk,bkhe->bqhe', a.astype(v.dtype), v)

    out = lax.map(one_block, (jnp.arange(nb), to_blocks(q1), to_blocks(q2)))
    return out.transpose(1, 0, 2, 3, 4).reshape(B, T, H, V_DIM)


def setup_inputs(seed: int = 0) -> dict:
    key = jax.random.key(seed)
    ks = jax.random.split(key, 24)
    f32 = jnp.float32
    L = DEPTH

    def nrm(k, shape, s):
        return jax.random.normal(k, shape, f32) * s

    def gain(k, shape):
        return 1.0 + 0.02 * jax.random.normal(k, shape, f32)

    return {
        "x": jax.random.normal(ks[0], (BATCH, SEQ, D_MODEL), f32),
        "c": jax.random.normal(ks[1], (BATCH, D_MODEL), f32),
        "w_ada": nrm(ks[2], (L, D_MODEL, N_MOD * D_MODEL), D_MODEL ** -0.5),
        "b_ada": nrm(ks[3], (L, N_MOD * D_MODEL), 0.01),
        "pre_norm1": gain(ks[4], (L, D_MODEL)),
        "post_norm1": gain(ks[5], (L, D_MODEL)),
        "w_in": nrm(ks[6], (L, D_MODEL, D_IN), D_MODEL ** -0.5),
        "conv_w": nrm(ks[7], (L, CONV_WIDTH, D_CONV), CONV_WIDTH ** -0.5),
        "conv_b": nrm(ks[8], (L, D_CONV), 0.01),
        "conv_ln_g": gain(ks[9], (L, D_CONV)),
        "conv_ln_b": nrm(ks[10], (L, D_CONV), 0.01),
        "conv_w_out": nrm(ks[11], (L, D_CONV, D_MODEL), D_CONV ** -0.5),
        "conv_b_out": nrm(ks[12], (L, D_MODEL), 0.01),
        "lambda_q1": nrm(ks[13], (L, HEAD_DIM), 0.1),
        "lambda_k1": nrm(ks[14], (L, HEAD_DIM), 0.1),
        "lambda_q2": nrm(ks[15], (L, HEAD_DIM), 0.1),
        "lambda_k2": nrm(ks[16], (L, HEAD_DIM), 0.1),
        "head_norm": gain(ks[17], (L, V_DIM)),
        "w_o": nrm(ks[18], (L, D_MODEL, D_MODEL), D_MODEL ** -0.5),
        "pre_norm2": gain(ks[19], (L, D_MODEL)),
        "post_norm2": gain(ks[20], (L, D_MODEL)),
        "w_ff1": nrm(ks[21], (L, D_MODEL, D_FF), D_MODEL ** -0.5),
        "w_ff2": nrm(ks[22], (L, D_FF, D_MODEL), D_FF ** -0.5),
    }


def reference(x, c, w_ada, b_ada, pre_norm1, post_norm1, w_in, conv_w, conv_b, conv_ln_g,
              conv_ln_b, conv_w_out, conv_b_out, lambda_q1, lambda_k1, lambda_q2, lambda_k2,
              head_norm, w_o, pre_norm2, post_norm2, w_ff1, w_ff2):
    B, T, _ = x.shape
    pos = jnp.arange(T)
    cs = jax.nn.silu(c)
    for l in range(DEPTH):
        mod = (cs @ w_ada[l] + b_ada[l])[:, None, :]
        sh1, sc1, g1, sh2, sc2, g2 = jnp.split(mod, N_MOD, axis=-1)

        h = rms_norm(x, pre_norm1[l]) * (1.0 + sc1) + sh1
        proj = h @ w_in[l]
        o1 = 2 * D_CONV
        o2 = o1 + D_QK
        o3 = o2 + D_QK
        o4 = o3 + D_V
        u_glu, q, k, v, gate_logits = proj[..., :o1], proj[..., o1:o2], proj[..., o2:o3], proj[..., o3:o4], proj[..., o4:]

        ua, ub = jnp.split(u_glu, 2, axis=-1)
        u = ua * jax.nn.sigmoid(ub)
        u = lax.conv_general_dilated(
            u, conv_w[l][:, None, :].astype(u.dtype), window_strides=(1,),
            padding=[(CONV_WIDTH - 1, 0)], dimension_numbers=('NWC', 'WIO', 'NWC'),
            feature_group_count=D_CONV) + conv_b[l]
        u = jax.nn.silu(layer_norm(u, conv_ln_g[l], conv_ln_b[l]))
        y_conv = u @ conv_w_out[l] + conv_b_out[l]

        q = q.reshape(B, T, 2, N_HEADS, HEAD_DIM)
        k = k.reshape(B, T, 2, N_HEADS, HEAD_DIM)
        v = v.reshape(B, T, N_HEADS, V_DIM)
        q1, q2 = rope(q[:, :, 0], pos), rope(q[:, :, 1], pos)
        k1, k2 = rope(k[:, :, 0], pos), rope(k[:, :, 1], pos)
        lam_init = lambda_init(l + 1)
        lam = (jnp.exp(jnp.sum(lambda_q1[l].astype(jnp.float32) * lambda_k1[l].astype(jnp.float32)))
               - jnp.exp(jnp.sum(lambda_q2[l].astype(jnp.float32) * lambda_k2[l].astype(jnp.float32)))
               + lam_init)
        att = causal_diff_attention(q1, q2, k1, k2, v, lam)
        att = rms_norm(att, head_norm[l]) * (1.0 - lam_init)
        y_att = att.reshape(B, T, D_V)

        g_conv, g_att = jnp.split(jax.nn.sigmoid(gate_logits), N_BRANCH, axis=-1)
        y = (g_conv * y_conv + g_att * y_att) @ w_o[l]
        x = x + g1 * rms_norm(y, post_norm1[l])

        h = rms_norm(x, pre_norm2[l]) * (1.0 + sc2) + sh2
        f = jnp.square(jax.nn.relu(h @ w_ff1[l])) @ w_ff2[l]
        x = x + g2 * rms_norm(f, post_norm2[l])
    return x
```

```cpp
#include <hip/hip_runtime.h>
#include <cstdio>
#include <cstdint>
#include <cmath>

constexpr int BATCH = 4, T = 8192, D = 1024, M = BATCH * T, DIN = 7168, FF = 4096, NH = 8, HD = 64, VD = 128, CWID = 31;
constexpr float EPS = 1e-6f, LAM_INIT = 0.2f;
constexpr float C2 = 0.18033688011112042f;

typedef unsigned short bf16;
__device__ __forceinline__ float bf2f(bf16 v) { return __uint_as_float(((unsigned)v) << 16); }
__device__ __forceinline__ unsigned f2bf(float f) { unsigned u = __float_as_uint(f); return (u + 0x7fffu + ((u >> 16) & 1u)) >> 16; }
__device__ __forceinline__ unsigned pk2(float lo, float hi) { return f2bf(lo) | (f2bf(hi) << 16); }
__device__ __forceinline__ float sigmoidf_(float v) { return 1.f / (1.f + __expf(-v)); }

constexpr size_t MiB = 1u << 20;
constexpr size_t WS_CTL = 0;
constexpr size_t WS_MOD = 1 * MiB;
constexpr size_t WS_ROPE = 1 * MiB + 512 * 1024;
constexpr size_t WS_R0 = 40 * MiB;
constexpr size_t RSZ = 64 * MiB;
constexpr size_t WS_END = WS_R0 + 7 * RSZ;

__device__ __forceinline__ float block_sum256(float v, float* red) {
#pragma unroll
    for (int o = 1; o < 64; o <<= 1) v += __shfl_xor(v, o);
    __syncthreads();
    if ((threadIdx.x & 63) == 0) red[threadIdx.x >> 6] = v;
    __syncthreads();
    return (red[0] + red[1]) + (red[2] + red[3]);
}

__global__ void __launch_bounds__(256) nv_mod(const float* c, const float* w_ada, const float* b_ada, const float* lq1, const float* lk1, const float* lq2, const float* lk2, float* mod) {
    const int col = blockIdx.x * 256 + threadIdx.x, b = blockIdx.y;
    float acc = 0.f;
    for (int k = 0; k < D; ++k) { const float cv = c[b * D + k]; acc += (cv * sigmoidf_(cv)) * w_ada[(size_t)k * 6144 + col]; }
    mod[b * 6144 + col] = acc + b_ada[col];
    if (blockIdx.x == 0 && blockIdx.y == 0 && threadIdx.x == 0) {
        float s1 = 0.f, s2 = 0.f;
        for (int i = 0; i < 64; ++i) { s1 += lq1[i] * lk1[i]; s2 += lq2[i] * lk2[i]; }
        mod[4 * 6144] = __expf(s1) - __expf(s2) + LAM_INIT;
    }
}

__global__ void __launch_bounds__(256) nv_h1(const float* x, const float* mod, const float* g, bf16* XN) {
    __shared__ float red[4];
    const int row = blockIdx.x, b = row / T, tid = threadIdx.x, c0 = tid * 4;
    const float4 v = ((const float4*)(x + (size_t)row * D))[tid];
    const float ss = block_sum256(v.x * v.x + v.y * v.y + v.z * v.z + v.w * v.w, red);
    const float rstd = rsqrtf(ss * (1.f / D) + EPS);
    const float* sh = mod + b * 6144; const float* sc = sh + 1024;
    const float vv[4] = {v.x, v.y, v.z, v.w}; float o[4];
#pragma unroll
    for (int j = 0; j < 4; ++j) o[j] = vv[j] * rstd * g[c0 + j] * (1.f + sc[c0 + j]) + sh[c0 + j];
    uint2 w; w.x = pk2(o[0], o[1]); w.y = pk2(o[2], o[3]);
    *(uint2*)(XN + (size_t)row * D + c0) = w;
}

template <class E> __global__ void __launch_bounds__(256) nv_gemm(const bf16* A, int K, const float* W, int ldw, E e) {
    __shared__ float As[64][36];
    const int tid = threadIdx.x, ix = tid & 63, iy = tid >> 6;
    const int row0 = blockIdx.x * 64, item = blockIdx.y * 64 + ix;
    int c0, c1; e.cols(item, c0, c1);
    float acc0[16], acc1[16];
#pragma unroll
    for (int r = 0; r < 16; ++r) { acc0[r] = 0.f; acc1[r] = 0.f; }
    for (int k0 = 0; k0 < K; k0 += 32) {
        { const int r = tid >> 2, kc = (tid & 3) * 8;
          const uint4 raw = *(const uint4*)(A + (size_t)(row0 + r) * K + k0 + kc);
          const unsigned w[4] = {raw.x, raw.y, raw.z, raw.w};
#pragma unroll
          for (int j = 0; j < 4; ++j) { As[r][kc + 2 * j] = __uint_as_float(w[j] << 16); As[r][kc + 2 * j + 1] = __uint_as_float(w[j] & 0xffff0000u); } }
        __syncthreads();
#pragma unroll 2
        for (int kk = 0; kk < 32; kk += 4) {
            float w0[4], w1[4];
#pragma unroll
            for (int j = 0; j < 4; ++j) { w0[j] = W[(size_t)(k0 + kk + j) * ldw + c0]; w1[j] = W[(size_t)(k0 + kk + j) * ldw + c1]; }
#pragma unroll
            for (int r = 0; r < 16; ++r) { const float4 a = *(const float4*)&As[iy * 16 + r][kk];
                acc0[r] += a.x * w0[0] + a.y * w0[1] + a.z * w0[2] + a.w * w0[3];
                acc1[r] += a.x * w1[0] + a.y * w1[1] + a.z * w1[2] + a.w * w1[3]; }
        }
        __syncthreads();
    }
#pragma unroll
    for (int r = 0; r < 16; ++r) e.store(row0 + iy * 16 + r, item, acc0[r], acc1[r]);
}

struct NvProj {
    bf16 *U, *Q, *Kb, *V, *GC, *GA;
    __device__ void cols(int item, int& c0, int& c1) const {
        if (item < 1024) { c0 = item; c1 = 1024 + item; }
        else if (item < 2048) { const int i = item - 1024, qk = i >> 9, j = i & 511, mh = j >> 5, d = j & 31; c0 = 2048 + qk * 1024 + mh * 64 + d; c1 = c0 + 32; }
        else if (item < 2560) { const int i = item - 2048; c0 = 4096 + i; c1 = 4096 + 512 + i; }
        else { const int i = item - 2560; c0 = 5120 + i; c1 = 6144 + i; }
    }
    __device__ void store(int row, int item, float a0, float a1) const {
        if (item < 1024) { U[(size_t)row * D + item] = (bf16)f2bf(a0 * sigmoidf_(a1)); }
        else if (item < 2048) { const int i = item - 1024, qk = i >> 9, j = i & 511, mh = j >> 5, d = j & 31; const int t = row % T;
            const float invf = powf(10000.f, -(float)d / 32.f), ang = (float)t * invf; const float cs = cosf(ang), sn = sinf(ang);
            float o1 = a0 * cs - a1 * sn, o2 = a1 * cs + a0 * sn; bf16* P = qk ? Kb : Q; if (!qk) { o1 *= C2; o2 *= C2; }
            P[(size_t)row * D + mh * 64 + d] = (bf16)f2bf(o1); P[(size_t)row * D + mh * 64 + 32 + d] = (bf16)f2bf(o2); }
        else if (item < 2560) { const int i = item - 2048; V[(size_t)row * D + i] = (bf16)f2bf(a0); V[(size_t)row * D + 512 + i] = (bf16)f2bf(a1); }
        else { const int i = item - 2560; GC[(size_t)row * D + i] = (bf16)f2bf(sigmoidf_(a0)); GA[(size_t)row * D + i] = (bf16)f2bf(sigmoidf_(a1)); }
    }
};
template <int MODE> struct NvPlain {
    bf16* O; int ldo, nhalf; const float* bias; const bf16* G;
    __device__ void cols(int item, int& c0, int& c1) const { c0 = item; c1 = nhalf + item; }
    __device__ float f(int row, int c, float a) const {
        if (MODE == 1) return bf2f(G[(size_t)row * ldo + c]) * (a + bias[c]);
        if (MODE == 2) { const float r = a > 0.f ? a : 0.f; return r * r; }
        return a; }
    __device__ void store(int row, int item, float a0, float a1) const {
        O[(size_t)row * ldo + item] = (bf16)f2bf(f(row, item, a0)); O[(size_t)row * ldo + nhalf + item] = (bf16)f2bf(f(row, nhalf + item, a1)); }
};

__global__ void __launch_bounds__(256) nv_conv(const bf16* U, const float* cw, const float* cb, const float* lg, const float* lb, bf16* UC) {
    __shared__ float red[4];
    const int row = blockIdx.x, t = row % T, tid = threadIdx.x, c0 = tid * 4;
    float a[4];
#pragma unroll
    for (int j = 0; j < 4; ++j) a[j] = cb[c0 + j];
    for (int i = 0; i < CWID; ++i) { const int tt = t - (CWID - 1) + i; if (tt < 0) continue;
        const uint2 raw = *(const uint2*)(U + (size_t)(row - (CWID - 1) + i) * D + c0);
        const float4 w = *(const float4*)(cw + (size_t)i * D + c0);
        a[0] += __uint_as_float(raw.x << 16) * w.x; a[1] += __uint_as_float(raw.x & 0xffff0000u) * w.y;
        a[2] += __uint_as_float(raw.y << 16) * w.z; a[3] += __uint_as_float(raw.y & 0xffff0000u) * w.w; }
    const float mean = block_sum256((a[0] + a[1]) + (a[2] + a[3]), red) * (1.f / D);
    float q = 0.f;
#pragma unroll
    for (int j = 0; j < 4; ++j) { a[j] -= mean; q += a[j] * a[j]; }
    const float rstd = rsqrtf(block_sum256(q, red) * (1.f / D) + EPS);
    float o[4];
#pragma unroll
    for (int j = 0; j < 4; ++j) { const float y = a[j] * rstd * lg[c0 + j] + lb[c0 + j]; o[j] = y * sigmoidf_(y); }
    uint2 w; w.x = pk2(o[0], o[1]); w.y = pk2(o[2], o[3]);
    *(uint2*)(UC + (size_t)row * D + c0) = w;
}

__global__ void __launch_bounds__(128) nv_attn(const bf16* Q, const bf16* Kb, const bf16* V, bf16* O1, bf16* O2) {
    __shared__ float Ks[64][64]; __shared__ float Vs[64][64];
    const int tid = threadIdx.x, qb = blockIdx.x, vhd = blockIdx.y, b = blockIdx.z;
    const int s = vhd >> 4, h = (vhd >> 1) & 7, vh = vhd & 1, mh = s * 8 + h;
    const int qi = qb * 128 + tid; const size_t rowbase = (size_t)b * T;
    float q[64], o[64];
    { const bf16* qp = Q + (rowbase + qi) * D + mh * 64;
#pragma unroll
      for (int d = 0; d < 64; d += 2) { const unsigned w = *(const unsigned*)(qp + d); q[d] = __uint_as_float(w << 16); q[d + 1] = __uint_as_float(w & 0xffff0000u); } }
#pragma unroll
    for (int e = 0; e < 64; ++e) o[e] = 0.f;
    float m = -1e30f, l = 0.f;
    const int nt = (qb * 128 + 128) / 64;
    for (int kt = 0; kt < nt; ++kt) {
        __syncthreads();
        for (int i = tid; i < 64 * 32; i += 128) { const int r = i >> 5, c = (i & 31) * 2;
            const unsigned kw = *(const unsigned*)(Kb + (rowbase + kt * 64 + r) * D + mh * 64 + c);
            const unsigned vw = *(const unsigned*)(V + (rowbase + kt * 64 + r) * D + h * 128 + vh * 64 + c);
            Ks[r][c] = __uint_as_float(kw << 16); Ks[r][c + 1] = __uint_as_float(kw & 0xffff0000u);
            Vs[r][c] = __uint_as_float(vw << 16); Vs[r][c + 1] = __uint_as_float(vw & 0xffff0000u); }
        __syncthreads();
        for (int j = 0; j < 64; ++j) {
            if (kt * 64 + j > qi) break;
            float sdot = 0.f;
#pragma unroll
            for (int d = 0; d < 64; d += 4) { const float4 kv = *(const float4*)&Ks[j][d]; sdot += q[d] * kv.x + q[d + 1] * kv.y + q[d + 2] * kv.z + q[d + 3] * kv.w; }
            if (sdot > m) { const float f = exp2f(m - sdot); l *= f;
#pragma unroll
                for (int e = 0; e < 64; ++e) o[e] *= f;
                m = sdot; }
            const float p = exp2f(sdot - m); l += p;
#pragma unroll
            for (int e = 0; e < 64; e += 4) { const float4 vv = *(const float4*)&Vs[j][e]; o[e] += p * vv.x; o[e + 1] += p * vv.y; o[e + 2] += p * vv.z; o[e + 3] += p * vv.w; }
        }
    }
    const float rl = 1.f / l; bf16* op = (s ? O2 : O1) + (rowbase + qi) * D + h * 128 + vh * 64;
#pragma unroll
    for (int e = 0; e < 64; e += 2) *(unsigned*)(op + e) = pk2(o[e] * rl, o[e + 1] * rl);
}

__global__ void __launch_bounds__(256) nv_combine(const bf16* O1, const bf16* O2, const bf16* YC, const bf16* GA, const float* hn, const float* mod, bf16* Z) {
    const int row = blockIdx.x, tid = threadIdx.x, c0 = tid * 4; const float lam = mod[4 * 6144];
    const size_t off = (size_t)row * D + c0;
    const uint2 r1 = *(const uint2*)(O1 + off), r2 = *(const uint2*)(O2 + off), ry = *(const uint2*)(YC + off), rg = *(const uint2*)(GA + off);
    float a[4] = {__uint_as_float(r1.x << 16) - lam * __uint_as_float(r2.x << 16), __uint_as_float(r1.x & 0xffff0000u) - lam * __uint_as_float(r2.x & 0xffff0000u),
                  __uint_as_float(r1.y << 16) - lam * __uint_as_float(r2.y << 16), __uint_as_float(r1.y & 0xffff0000u) - lam * __uint_as_float(r2.y & 0xffff0000u)};
    float ss = (a[0] * a[0] + a[1] * a[1]) + (a[2] * a[2] + a[3] * a[3]);
#pragma unroll
    for (int o = 1; o < 32; o <<= 1) ss += __shfl_xor(ss, o);
    const float rstd = rsqrtf(ss * (1.f / VD) + EPS) * (1.f - LAM_INIT);
    const float yc[4] = {__uint_as_float(ry.x << 16), __uint_as_float(ry.x & 0xffff0000u), __uint_as_float(ry.y << 16), __uint_as_float(ry.y & 0xffff0000u)};
    const float ga[4] = {__uint_as_float(rg.x << 16), __uint_as_float(rg.x & 0xffff0000u), __uint_as_float(rg.y << 16), __uint_as_float(rg.y & 0xffff0000u)};
    float z[4];
#pragma unroll
    for (int j = 0; j < 4; ++j) z[j] = yc[j] + ga[j] * (a[j] * rstd * hn[(c0 + j) & 127]);
    uint2 w; w.x = pk2(z[0], z[1]); w.y = pk2(z[2], z[3]);
    *(uint2*)(Z + off) = w;
}

__global__ void __launch_bounds__(256) nv_x1(const float* x, const bf16* Y, const float* mod, const float* post1, const float* pre2, float* out, bf16* XN) {
    __shared__ float red[4];
    const int row = blockIdx.x, b = row / T, tid = threadIdx.x, c0 = tid * 4;
    const uint2 ry = *(const uint2*)(Y + (size_t)row * D + c0);
    const float y[4] = {__uint_as_float(ry.x << 16), __uint_as_float(ry.x & 0xffff0000u), __uint_as_float(ry.y << 16), __uint_as_float(ry.y & 0xffff0000u)};
    const float rstd = rsqrtf(block_sum256((y[0] * y[0] + y[1] * y[1]) + (y[2] * y[2] + y[3] * y[3]), red) * (1.f / D) + EPS);
    const float* mb = mod + b * 6144; const float4 xv = ((const float4*)(x + (size_t)row * D))[tid];
    const float xx[4] = {xv.x, xv.y, xv.z, xv.w}; float x1[4]; float ss = 0.f;
#pragma unroll
    for (int j = 0; j < 4; ++j) { x1[j] = xx[j] + mb[2048 + c0 + j] * (y[j] * rstd * post1[c0 + j]); ss += x1[j] * x1[j]; }
    ((float4*)(out + (size_t)row * D))[tid] = make_float4(x1[0], x1[1], x1[2], x1[3]);
    const float rstd2 = rsqrtf(block_sum256(ss, red) * (1.f / D) + EPS);
    float o[4];
#pragma unroll
    for (int j = 0; j < 4; ++j) o[j] = x1[j] * rstd2 * pre2[c0 + j] * (1.f + mb[4096 + c0 + j]) + mb[3072 + c0 + j];
    uint2 w; w.x = pk2(o[0], o[1]); w.y = pk2(o[2], o[3]);
    *(uint2*)(XN + (size_t)row * D + c0) = w;
}
__global__ void __launch_bounds__(256) nv_out(const bf16* F, const float* mod, const float* post2, float* out) {
    __shared__ float red[4];
    const int row = blockIdx.x, b = row / T, tid = threadIdx.x, c0 = tid * 4;
    const uint2 rf = *(const uint2*)(F + (size_t)row * D + c0);
    const float f[4] = {__uint_as_float(rf.x << 16), __uint_as_float(rf.x & 0xffff0000u), __uint_as_float(rf.y << 16), __uint_as_float(rf.y & 0xffff0000u)};
    const float rstd = rsqrtf(block_sum256((f[0] * f[0] + f[1] * f[1]) + (f[2] * f[2] + f[3] * f[3]), red) * (1.f / D) + EPS);
    const float* mb = mod + b * 6144; float4 xv = ((const float4*)(out + (size_t)row * D))[tid];
    xv.x += mb[5120 + c0 + 0] * (f[0] * rstd * post2[c0 + 0]); xv.y += mb[5120 + c0 + 1] * (f[1] * rstd * post2[c0 + 1]);
    xv.z += mb[5120 + c0 + 2] * (f[2] * rstd * post2[c0 + 2]); xv.w += mb[5120 + c0 + 3] * (f[3] * rstd * post2[c0 + 3]);
    ((float4*)(out + (size_t)row * D))[tid] = xv;
}

extern "C" void kernel_launch(void* const* d_in, const int* in_sizes, int n_in, void* d_out, int out_size, void* d_ws, size_t ws_size, hipStream_t stream) {
    if (n_in != 23 || in_sizes[0] != M * D || out_size != M * D || ws_size < WS_END) { fprintf(stderr, "kernel_launch: unexpected shapes (n_in %d in0 %d out %d ws %zu)\n", n_in, n_in > 0 ? in_sizes[0] : -1, out_size, ws_size); return; }
    const float* x = (const float*)d_in[0]; const float* c = (const float*)d_in[1]; const float* w_ada = (const float*)d_in[2]; const float* b_ada = (const float*)d_in[3];
    const float* pre1 = (const float*)d_in[4]; const float* post1 = (const float*)d_in[5]; const float* w_in = (const float*)d_in[6]; const float* conv_w = (const float*)d_in[7];
    const float* conv_b = (const float*)d_in[8]; const float* ln_g = (const float*)d_in[9]; const float* ln_b = (const float*)d_in[10]; const float* wc_out = (const float*)d_in[11];
    const float* bc_out = (const float*)d_in[12]; const float* lq1 = (const float*)d_in[13]; const float* lk1 = (const float*)d_in[14]; const float* lq2 = (const float*)d_in[15];
    const float* lk2 = (const float*)d_in[16]; const float* hn = (const float*)d_in[17]; const float* w_o = (const float*)d_in[18]; const float* pre2 = (const float*)d_in[19];
    const float* post2 = (const float*)d_in[20]; const float* w1 = (const float*)d_in[21]; const float* w2 = (const float*)d_in[22];
    float* out = (float*)d_out; unsigned char* ws = (unsigned char*)d_ws;
    float* mod = (float*)(ws + WS_MOD);
    bf16* R[7]; for (int i = 0; i < 7; ++i) R[i] = (bf16*)(ws + WS_R0 + i * RSZ);
    bf16 *XN = R[0], *U = R[1], *Q = R[2], *Kb = R[3], *V = R[4], *GC = R[5], *GA = R[6];
    bf16 *UC = R[0], *YC = R[1], *O1 = R[0], *O2 = R[5], *Z = R[2], *Y = R[3], *F1 = R[1], *F = R[5];

    nv_mod<<<dim3(6144 / 256, BATCH), 256, 0, stream>>>(c, w_ada, b_ada, lq1, lk1, lq2, lk2, mod);
    nv_h1<<<M, 256, 0, stream>>>(x, mod, pre1, XN);
    nv_gemm<NvProj><<<dim3(M / 64, 3584 / 64), 256, 0, stream>>>(XN, D, w_in, DIN, NvProj{U, Q, Kb, V, GC, GA});
    nv_conv<<<M, 256, 0, stream>>>(U, conv_w, conv_b, ln_g, ln_b, UC);
    nv_gemm<NvPlain<1>><<<dim3(M / 64, 512 / 64), 256, 0, stream>>>(UC, D, wc_out, D, NvPlain<1>{YC, D, 512, bc_out, GC});
    nv_attn<<<dim3(T / 128, 32, BATCH), 128, 0, stream>>>(Q, Kb, V, O1, O2);
    nv_combine<<<M, 256, 0, stream>>>(O1, O2, YC, GA, hn, mod, Z);
    nv_gemm<NvPlain<0>><<<dim3(M / 64, 512 / 64), 256, 0, stream>>>(Z, D, w_o, D, NvPlain<0>{Y, D, 512, nullptr, nullptr});
    nv_x1<<<M, 256, 0, stream>>>(x, Y, mod, post1, pre2, out, XN);
    nv_gemm<NvPlain<2>><<<dim3(M / 64, 2048 / 64), 256, 0, stream>>>(XN, D, w1, FF, NvPlain<2>{F1, FF, 2048, nullptr, nullptr});
    nv_gemm<NvPlain<0>><<<dim3(M / 64, 512 / 64), 256, 0, stream>>>(F1, FF, w2, D, NvPlain<0>{F, D, 512, nullptr, nullptr});
    nv_out<<<M, 256, 0, stream>>>(F, mod, post2, out);
}
```

```cpp
#include <hip/hip_runtime.h>
#include <cstdio>
#include <cstdint>
#include <cmath>

constexpr int BATCH = 4, T = 8192, D = 1024, M = BATCH * T, DIN = 7168, FF = 4096, NH = 8, HD = 64, VD = 128, CWID = 31;
constexpr float EPS = 1e-6f, LAM_INIT = 0.2f;
constexpr float C2 = 0.18033688011112042f;

typedef unsigned short bf16;
__device__ __forceinline__ float bf2f(bf16 v) { return __uint_as_float(((unsigned)v) << 16); }
__device__ __forceinline__ unsigned f2bf(float f) { unsigned u = __float_as_uint(f); return (u + 0x7fffu + ((u >> 16) & 1u)) >> 16; }
__device__ __forceinline__ unsigned pk2(float lo, float hi) { return f2bf(lo) | (f2bf(hi) << 16); }
__device__ __forceinline__ float sigmoidf_(float v) { return 1.f / (1.f + __expf(-v)); }

constexpr size_t MiB = 1u << 20;
constexpr size_t WS_CTL = 0;
constexpr size_t WS_MOD = 1 * MiB;
constexpr size_t WS_ROPE = 1 * MiB + 512 * 1024;
constexpr size_t WS_R0 = 40 * MiB;
constexpr size_t RSZ = 64 * MiB;
constexpr size_t WS_END = WS_R0 + 7 * RSZ;

__device__ __forceinline__ float block_sum256(float v, float* red) {
#pragma unroll
    for (int o = 1; o < 64; o <<= 1) v += __shfl_xor(v, o);
    __syncthreads();
    if ((threadIdx.x & 63) == 0) red[threadIdx.x >> 6] = v;
    __syncthreads();
    return (red[0] + red[1]) + (red[2] + red[3]);
}

__global__ void __launch_bounds__(256) nv_mod(const float* c, const float* w_ada, const float* b_ada, const float* lq1, const float* lk1, const float* lq2, const float* lk2, float* mod) {
    const int col = blockIdx.x * 256 + threadIdx.x, b = blockIdx.y;
    float acc = 0.f;
    for (int k = 0; k < D; ++k) { const float cv = c[b * D + k]; acc += (cv * sigmoidf_(cv)) * w_ada[(size_t)k * 6144 + col]; }
    mod[b * 6144 + col] = acc + b_ada[col];
    if (blockIdx.x == 0 && blockIdx.y == 0 && threadIdx.x == 0) {
        float s1 = 0.f, s2 = 0.f;
        for (int i = 0; i < 64; ++i) { s1 += lq1[i] * lk1[i]; s2 += lq2[i] * lk2[i]; }
        mod[4 * 6144] = __expf(s1) - __expf(s2) + LAM_INIT;
    }
}

__global__ void __launch_bounds__(256) nv_h1(const float* x, const float* mod, const float* g, bf16* XN) {
    __shared__ float red[4];
    const int row = blockIdx.x, b = row / T, tid = threadIdx.x, c0 = tid * 4;
    const float4 v = ((const float4*)(x + (size_t)row * D))[tid];
    const float ss = block_sum256(v.x * v.x + v.y * v.y + v.z * v.z + v.w * v.w, red);
    const float rstd = rsqrtf(ss * (1.f / D) + EPS);
    const float* sh = mod + b * 6144; const float* sc = sh + 1024;
    const float vv[4] = {v.x, v.y, v.z, v.w}; float o[4];
#pragma unroll
    for (int j = 0; j < 4; ++j) o[j] = vv[j] * rstd * g[c0 + j] * (1.f + sc[c0 + j]) + sh[c0 + j];
    uint2 w; w.x = pk2(o[0], o[1]); w.y = pk2(o[2], o[3]);
    *(uint2*)(XN + (size_t)row * D + c0) = w;
}

template <class E> __global__ void __launch_bounds__(256) nv_gemm(const bf16* A, int K, const float* W, int ldw, E e, int yoff = 0) {
    __shared__ float As[64][36];
    const int tid = threadIdx.x, ix = tid & 63, iy = tid >> 6;
    const int row0 = blockIdx.x * 64, item = (blockIdx.y + yoff) * 64 + ix;
    int c0, c1; e.cols(item, c0, c1);
    float acc0[16], acc1[16];
#pragma unroll
    for (int r = 0; r < 16; ++r) { acc0[r] = 0.f; acc1[r] = 0.f; }
    for (int k0 = 0; k0 < K; k0 += 32) {
        { const int r = tid >> 2, kc = (tid & 3) * 8;
          const uint4 raw = *(const uint4*)(A + (size_t)(row0 + r) * K + k0 + kc);
          const unsigned w[4] = {raw.x, raw.y, raw.z, raw.w};
#pragma unroll
          for (int j = 0; j < 4; ++j) { As[r][kc + 2 * j] = __uint_as_float(w[j] << 16); As[r][kc + 2 * j + 1] = __uint_as_float(w[j] & 0xffff0000u); } }
        __syncthreads();
#pragma unroll 2
        for (int kk = 0; kk < 32; kk += 4) {
            float w0[4], w1[4];
#pragma unroll
            for (int j = 0; j < 4; ++j) { w0[j] = W[(size_t)(k0 + kk + j) * ldw + c0]; w1[j] = W[(size_t)(k0 + kk + j) * ldw + c1]; }
#pragma unroll
            for (int r = 0; r < 16; ++r) { const float4 a = *(const float4*)&As[iy * 16 + r][kk];
                acc0[r] += a.x * w0[0] + a.y * w0[1] + a.z * w0[2] + a.w * w0[3];
                acc1[r] += a.x * w1[0] + a.y * w1[1] + a.z * w1[2] + a.w * w1[3]; }
        }
        __syncthreads();
    }
#pragma unroll
    for (int r = 0; r < 16; ++r) e.store(row0 + iy * 16 + r, item, acc0[r], acc1[r]);
}

struct NvProj {
    bf16 *U, *Q, *Kb, *V, *GC, *GA;
    __device__ void cols(int item, int& c0, int& c1) const {
        if (item < 1024) { c0 = item; c1 = 1024 + item; }
        else if (item < 2048) { const int i = item - 1024, qk = i >> 9, j = i & 511, mh = j >> 5, d = j & 31; c0 = 2048 + qk * 1024 + mh * 64 + d; c1 = c0 + 32; }
        else if (item < 2560) { const int i = item - 2048; c0 = 4096 + i; c1 = 4096 + 512 + i; }
        else { const int i = item - 2560; c0 = 5120 + i; c1 = 6144 + i; }
    }
    __device__ void store(int row, int item, float a0, float a1) const {
        if (item < 1024) { U[(size_t)row * D + item] = (bf16)f2bf(a0 * sigmoidf_(a1)); }
        else if (item < 2048) { const int i = item - 1024, qk = i >> 9, j = i & 511, mh = j >> 5, d = j & 31; const int t = row % T;
            const float invf = powf(10000.f, -(float)d / 32.f), ang = (float)t * invf; const float cs = cosf(ang), sn = sinf(ang);
            float o1 = a0 * cs - a1 * sn, o2 = a1 * cs + a0 * sn; bf16* P = qk ? Kb : Q; if (!qk) { o1 *= C2; o2 *= C2; }
            P[(size_t)row * D + mh * 64 + d] = (bf16)f2bf(o1); P[(size_t)row * D + mh * 64 + 32 + d] = (bf16)f2bf(o2); }
        else if (item < 2560) { const int i = item - 2048; V[(size_t)row * D + i] = (bf16)f2bf(a0); V[(size_t)row * D + 512 + i] = (bf16)f2bf(a1); }
        else { const int i = item - 2560; GC[(size_t)row * D + i] = (bf16)f2bf(sigmoidf_(a0)); GA[(size_t)row * D + i] = (bf16)f2bf(sigmoidf_(a1)); }
    }
};
template <int MODE> struct NvPlain {
    bf16* O; int ldo, nhalf; const float* bias; const bf16* G;
    __device__ void cols(int item, int& c0, int& c1) const { c0 = item; c1 = nhalf + item; }
    __device__ float f(int row, int c, float a) const {
        if (MODE == 1) return bf2f(G[(size_t)row * ldo + c]) * (a + bias[c]);
        if (MODE == 2) { const float r = a > 0.f ? a : 0.f; return r * r; }
        return a; }
    __device__ void store(int row, int item, float a0, float a1) const {
        O[(size_t)row * ldo + item] = (bf16)f2bf(f(row, item, a0)); O[(size_t)row * ldo + nhalf + item] = (bf16)f2bf(f(row, nhalf + item, a1)); }
};

__global__ void __launch_bounds__(256) nv_conv(const bf16* U, const float* cw, const float* cb, const float* lg, const float* lb, bf16* UC) {
    __shared__ float red[4];
    const int row = blockIdx.x, t = row % T, tid = threadIdx.x, c0 = tid * 4;
    float a[4];
#pragma unroll
    for (int j = 0; j < 4; ++j) a[j] = cb[c0 + j];
    for (int i = 0; i < CWID; ++i) { const int tt = t - (CWID - 1) + i; if (tt < 0) continue;
        const uint2 raw = *(const uint2*)(U + (size_t)(row - (CWID - 1) + i) * D + c0);
        const float4 w = *(const float4*)(cw + (size_t)i * D + c0);
        a[0] += __uint_as_float(raw.x << 16) * w.x; a[1] += __uint_as_float(raw.x & 0xffff0000u) * w.y;
        a[2] += __uint_as_float(raw.y << 16) * w.z; a[3] += __uint_as_float(raw.y & 0xffff0000u) * w.w; }
    const float mean = block_sum256((a[0] + a[1]) + (a[2] + a[3]), red) * (1.f / D);
    float q = 0.f;
#pragma unroll
    for (int j = 0; j < 4; ++j) { a[j] -= mean; q += a[j] * a[j]; }
    const float rstd = rsqrtf(block_sum256(q, red) * (1.f / D) + EPS);
    float o[4];
#pragma unroll
    for (int j = 0; j < 4; ++j) { const float y = a[j] * rstd * lg[c0 + j] + lb[c0 + j]; o[j] = y * sigmoidf_(y); }
    uint2 w; w.x = pk2(o[0], o[1]); w.y = pk2(o[2], o[3]);
    *(uint2*)(UC + (size_t)row * D + c0) = w;
}

__global__ void __launch_bounds__(128) nv_attn(const bf16* Q, const bf16* Kb, const bf16* V, bf16* O1, bf16* O2) {
    __shared__ float Ks[64][64]; __shared__ float Vs[64][64];
    const int tid = threadIdx.x, qb = blockIdx.x, vhd = blockIdx.y, b = blockIdx.z;
    const int s = vhd >> 4, h = (vhd >> 1) & 7, vh = vhd & 1, mh = s * 8 + h;
    const int qi = qb * 128 + tid; const size_t rowbase = (size_t)b * T;
    float q[64], o[64];
    { const bf16* qp = Q + (rowbase + qi) * D + mh * 64;
#pragma unroll
      for (int d = 0; d < 64; d += 2) { const unsigned w = *(const unsigned*)(qp + d); q[d] = __uint_as_float(w << 16); q[d + 1] = __uint_as_float(w & 0xffff0000u); } }
#pragma unroll
    for (int e = 0; e < 64; ++e) o[e] = 0.f;
    float m = -1e30f, l = 0.f;
    const int nt = (qb * 128 + 128) / 64;
    for (int kt = 0; kt < nt; ++kt) {
        __syncthreads();
        for (int i = tid; i < 64 * 32; i += 128) { const int r = i >> 5, c = (i & 31) * 2;
            const unsigned kw = *(const unsigned*)(Kb + (rowbase + kt * 64 + r) * D + mh * 64 + c);
            const unsigned vw = *(const unsigned*)(V + (rowbase + kt * 64 + r) * D + h * 128 + vh * 64 + c);
            Ks[r][c] = __uint_as_float(kw << 16); Ks[r][c + 1] = __uint_as_float(kw & 0xffff0000u);
            Vs[r][c] = __uint_as_float(vw << 16); Vs[r][c + 1] = __uint_as_float(vw & 0xffff0000u); }
        __syncthreads();
        for (int j = 0; j < 64; ++j) {
            if (kt * 64 + j > qi) break;
            float sdot = 0.f;
#pragma unroll
            for (int d = 0; d < 64; d += 4) { const float4 kv = *(const float4*)&Ks[j][d]; sdot += q[d] * kv.x + q[d + 1] * kv.y + q[d + 2] * kv.z + q[d + 3] * kv.w; }
            if (sdot > m) { const float f = exp2f(m - sdot); l *= f;
#pragma unroll
                for (int e = 0; e < 64; ++e) o[e] *= f;
                m = sdot; }
            const float p = exp2f(sdot - m); l += p;
#pragma unroll
            for (int e = 0; e < 64; e += 4) { const float4 vv = *(const float4*)&Vs[j][e]; o[e] += p * vv.x; o[e + 1] += p * vv.y; o[e + 2] += p * vv.z; o[e + 3] += p * vv.w; }
        }
    }
    const float rl = 1.f / l; bf16* op = (s ? O2 : O1) + (rowbase + qi) * D + h * 128 + vh * 64;
#pragma unroll
    for (int e = 0; e < 64; e += 2) *(unsigned*)(op + e) = pk2(o[e] * rl, o[e + 1] * rl);
}

__global__ void __launch_bounds__(256) nv_combine(const bf16* O1, const bf16* O2, const bf16* YC, const bf16* GA, const float* hn, const float* mod, bf16* Z) {
    const int row = blockIdx.x, tid = threadIdx.x, c0 = tid * 4; const float lam = mod[4 * 6144];
    const size_t off = (size_t)row * D + c0;
    const uint2 r1 = *(const uint2*)(O1 + off), r2 = *(const uint2*)(O2 + off), ry = *(const uint2*)(YC + off), rg = *(const uint2*)(GA + off);
    float a[4] = {__uint_as_float(r1.x << 16) - lam * __uint_as_float(r2.x << 16), __uint_as_float(r1.x & 0xffff0000u) - lam * __uint_as_float(r2.x & 0xffff0000u),
                  __uint_as_float(r1.y << 16) - lam * __uint_as_float(r2.y << 16), __uint_as_float(r1.y & 0xffff0000u) - lam * __uint_as_float(r2.y & 0xffff0000u)};
    float ss = (a[0] * a[0] + a[1] * a[1]) + (a[2] * a[2] + a[3] * a[3]);
#pragma unroll
    for (int o = 1; o < 32; o <<= 1) ss += __shfl_xor(ss, o);
    const float rstd = rsqrtf(ss * (1.f / VD) + EPS) * (1.f - LAM_INIT);
    const float yc[4] = {__uint_as_float(ry.x << 16), __uint_as_float(ry.x & 0xffff0000u), __uint_as_float(ry.y << 16), __uint_as_float(ry.y & 0xffff0000u)};
    const float ga[4] = {__uint_as_float(rg.x << 16), __uint_as_float(rg.x & 0xffff0000u), __uint_as_float(rg.y << 16), __uint_as_float(rg.y & 0xffff0000u)};
    float z[4];
#pragma unroll
    for (int j = 0; j < 4; ++j) z[j] = yc[j] + ga[j] * (a[j] * rstd * hn[(c0 + j) & 127]);
    uint2 w; w.x = pk2(z[0], z[1]); w.y = pk2(z[2], z[3]);
    *(uint2*)(Z + off) = w;
}

__global__ void __launch_bounds__(256) nv_x1(const float* x, const bf16* Y, const float* mod, const float* post1, const float* pre2, float* out, bf16* XN) {
    __shared__ float red[4];
    const int row = blockIdx.x, b = row / T, tid = threadIdx.x, c0 = tid * 4;
    const uint2 ry = *(const uint2*)(Y + (size_t)row * D + c0);
    const float y[4] = {__uint_as_float(ry.x << 16), __uint_as_float(ry.x & 0xffff0000u), __uint_as_float(ry.y << 16), __uint_as_float(ry.y & 0xffff0000u)};
    const float rstd = rsqrtf(block_sum256((y[0] * y[0] + y[1] * y[1]) + (y[2] * y[2] + y[3] * y[3]), red) * (1.f / D) + EPS);
    const float* mb = mod + b * 6144; const float4 xv = ((const float4*)(x + (size_t)row * D))[tid];
    const float xx[4] = {xv.x, xv.y, xv.z, xv.w}; float x1[4]; float ss = 0.f;
#pragma unroll
    for (int j = 0; j < 4; ++j) { x1[j] = xx[j] + mb[2048 + c0 + j] * (y[j] * rstd * post1[c0 + j]); ss += x1[j] * x1[j]; }
    ((float4*)(out + (size_t)row * D))[tid] = make_float4(x1[0], x1[1], x1[2], x1[3]);
    const float rstd2 = rsqrtf(block_sum256(ss, red) * (1.f / D) + EPS);
    float o[4];
#pragma unroll
    for (int j = 0; j < 4; ++j) o[j] = x1[j] * rstd2 * pre2[c0 + j] * (1.f + mb[4096 + c0 + j]) + mb[3072 + c0 + j];
    uint2 w; w.x = pk2(o[0], o[1]); w.y = pk2(o[2], o[3]);
    *(uint2*)(XN + (size_t)row * D + c0) = w;
}
__global__ void __launch_bounds__(256) nv_out(const bf16* F, const float* mod, const float* post2, float* out) {
    __shared__ float red[4];
    const int row = blockIdx.x, b = row / T, tid = threadIdx.x, c0 = tid * 4;
    const uint2 rf = *(const uint2*)(F + (size_t)row * D + c0);
    const float f[4] = {__uint_as_float(rf.x << 16), __uint_as_float(rf.x & 0xffff0000u), __uint_as_float(rf.y << 16), __uint_as_float(rf.y & 0xffff0000u)};
    const float rstd = rsqrtf(block_sum256((f[0] * f[0] + f[1] * f[1]) + (f[2] * f[2] + f[3] * f[3]), red) * (1.f / D) + EPS);
    const float* mb = mod + b * 6144; float4 xv = ((const float4*)(out + (size_t)row * D))[tid];
    xv.x += mb[5120 + c0 + 0] * (f[0] * rstd * post2[c0 + 0]); xv.y += mb[5120 + c0 + 1] * (f[1] * rstd * post2[c0 + 1]);
    xv.z += mb[5120 + c0 + 2] * (f[2] * rstd * post2[c0 + 2]); xv.w += mb[5120 + c0 + 3] * (f[3] * rstd * post2[c0 + 3]);
    ((float4*)(out + (size_t)row * D))[tid] = xv;
}


namespace pg8 {
#define PG8_LAS __attribute__((address_space(3)))
typedef unsigned short bf16_t;
typedef short bf16x8 __attribute__((ext_vector_type(8)));
typedef float f32x4 __attribute__((ext_vector_type(4)));
typedef unsigned u32x4 __attribute__((ext_vector_type(4)));
constexpr int BM = 256, BK = 64, HALF = 128, HTB = HALF * BK * 2  , STAGE_BYTES = 8 * HTB, NXCD = 8, WGM = 8;

__host__ __device__ __forceinline__ int lds_byte(int r, int c) { const int st = (r >> 4) * 2 + (c >> 5), rr = r & 15, cc = c & 31, ob = rr * 64 + cc * 2; return st * 1024 + (ob ^ (((ob >> 9) & 1) << 5)); }
__host__ __device__ __forceinline__ void stage_rc(int b, int& R, int& C) { const int st = b / 1024, sb = b % 1024, swz = sb ^ (((sb >> 9) & 1) << 5); R = (st >> 1) * 16 + swz / 64; C = (st & 1) * 32 + (swz % 64) / 2; }
__host__ __device__ __forceinline__ int perm32(int rho) { const int n = rho >> 4, i = rho & 15; return 8 * (i >> 2) + 4 * n + (i & 3); }

struct Unit { int pm, pn; };
struct Gemm { const bf16_t* A; const bf16_t* Bt; int M, N, K; };

struct StaticOrder {
    int nM, nN, nwg, G, c;
    __host__ __device__ void init(int M, int N, int G_, int c_) { nM = M / BM; nN = N / BM; nwg = nM * nN; G = G_; c = c_; }
    __host__ __device__ bool next(int i, Unit& u) const {
        const long L = (long)i * G + c; if (L >= nwg) return false;
        int wgid = (int)L; { const int q = nwg / NXCD, r = nwg % NXCD, xcd = wgid % NXCD, off = wgid / NXCD; wgid = (xcd < r ? xcd * (q + 1) : r * (q + 1) + (xcd - r) * q) + off; }
        const int nig = WGM * nN, gid = wgid / nig, fm = gid * WGM, gsz = (nM - fm) < WGM ? (nM - fm) : WGM;
        u.pm = fm + ((wgid % nig) % gsz); u.pn = (wgid % nig) / gsz; return true;
    }
    __device__ __forceinline__ void a_ready(const Unit&) const {}
    __device__ __forceinline__ void done(const Unit&) const {}
};

typedef float f32x2_cv __attribute__((ext_vector_type(2))); typedef __bf16 bf16x2_cv __attribute__((ext_vector_type(2)));
__device__ __forceinline__ unsigned cvt_pk_bf16(float lo, float hi) { f32x2_cv v = {lo, hi}; bf16x2_cv b = __builtin_convertvector(v, bf16x2_cv); return __builtin_bit_cast(unsigned, b); }
typedef float f32x2 __attribute__((ext_vector_type(2)));
template <class Epi, class Sched, bool ALIGN_EPI = false, bool SP2 = false>
__device__ __forceinline__ void gemm_phase(PG8_LAS unsigned char* lds, const Gemm g, const Sched& S, const Epi& E) {
    const int tid = threadIdx.x, wid = __builtin_amdgcn_readfirstlane(tid >> 6), lane = tid & 63, wr = wid >> 2, wc = wid & 3, fr = lane & 15, fq = lane >> 4;
    const int K = g.K, nt = K / BK;
    unsigned voffA[2], voffB[2];
#pragma unroll
    for (int i = 0; i < 2; ++i) { int R, C; stage_rc(tid * 16 + i * 8192, R, C); const int Rb = Epi::PERM ? ((R & ~31) + perm32(R & 31)) : R;
        voffA[i] = (unsigned)(R * K + C) * 2u; voffB[i] = (unsigned)(Rb * K + C) * 2u; }
    const size_t kstep = (size_t)(BK * 2);
    const size_t hstep = (size_t)HALF * K * 2;
    const size_t tstep = 2 * hstep;
    const unsigned ldsw = (unsigned)wid * 1024u;
    const int aoff = lds_byte(wr * 64 + fr, fq * 8), boff = lds_byte(wc * 32 + fr, fq * 8);
#define PG8_SA(b, h) (((b) * 2 + (h)) * HTB)
#define PG8_SB(b, h) ((4 + (b) * 2 + (h)) * HTB)
#define PG8_STAGE(bufoff, gbase, voff) do { _Pragma("unroll") for (int _i = 0; _i < 2; ++_i) \
        __builtin_amdgcn_global_load_lds((const unsigned*)((const char*)(gbase) + (voff)[_i]), (PG8_LAS unsigned*)(lds + (bufoff) + ldsw + _i * 8192), 16, 0, 0); } while (0)
#define PG8_LDA(dst, b, h) do { _Pragma("unroll") for (int m = 0; m < 4; ++m) _Pragma("unroll") for (int k = 0; k < 2; ++k) dst[m][k] = *(const PG8_LAS bf16x8*)(lds + PG8_SA(b, h) + aoff + m * 2048 + k * 1024); } while (0)
#define PG8_LDB(dst, b, h) do { _Pragma("unroll") for (int n = 0; n < 2; ++n) _Pragma("unroll") for (int k = 0; k < 2; ++k) dst[n][k] = *(const PG8_LAS bf16x8*)(lds + PG8_SB(b, h) + boff + n * 2048 + k * 1024); } while (0)
#define PG8_MMA(ai, bj, At, Bt) do { __builtin_amdgcn_s_setprio(1); _Pragma("unroll") for (int m = 0; m < 4; ++m) _Pragma("unroll") for (int n = 0; n < 2; ++n) _Pragma("unroll") for (int k = 0; k < 2; ++k) \
        acc[ai][bj][m][n] = __builtin_amdgcn_mfma_f32_16x16x32_bf16(Bt[n][k], At[m][k], acc[ai][bj][m][n], 0, 0, 0); __builtin_amdgcn_s_setprio(0); } while (0)
#define PG8_WAIT_V(n) asm volatile("s_waitcnt vmcnt(" #n ")" ::: "memory")
#define PG8_WAIT_L(n) asm volatile("s_waitcnt lgkmcnt(" #n ")" ::: "memory")
#define PG8_BAR __builtin_amdgcn_s_barrier()
#define PG8_SCHED __builtin_amdgcn_sched_barrier(0)
    Unit cur, nxt; int ui = 0;
    if (!S.next(0, cur)) return;
    f32x4 acc[2][2][4][2];
#pragma unroll
    for (int a = 0; a < 2; ++a)
#pragma unroll
        for (int b = 0; b < 2; ++b)
#pragma unroll
            for (int m = 0; m < 4; ++m)
#pragma unroll
                for (int n = 0; n < 2; ++n) acc[a][b][m][n] = (f32x4){0.f, 0.f, 0.f, 0.f};
    bf16x8 At[4][2], B0[2][2], B1[2][2];
    const char* cA = (const char*)g.A + (size_t)cur.pm * tstep; const char* cB = (const char*)g.Bt + (size_t)cur.pn * tstep;
    S.a_ready(cur);
    if constexpr (SP2) {
        PG8_STAGE(PG8_SB(0, 0), cB, voffB); PG8_STAGE(PG8_SB(0, 1), cB + hstep, voffB); PG8_STAGE(PG8_SA(0, 0), cA, voffA); PG8_STAGE(PG8_SA(0, 1), cA + hstep, voffA);
        if (wr == 1) PG8_BAR;
        PG8_WAIT_V(2); PG8_BAR;
        PG8_STAGE(PG8_SB(1, 0), cB + kstep, voffB); PG8_STAGE(PG8_SA(1, 0), cA + kstep, voffA); PG8_STAGE(PG8_SB(1, 1), cB + hstep + kstep, voffB);
        PG8_WAIT_V(6); PG8_BAR;
    } else {
        PG8_STAGE(PG8_SB(0, 0), cB, voffB); PG8_STAGE(PG8_SA(0, 0), cA, voffA); PG8_STAGE(PG8_SB(0, 1), cB + hstep, voffB); PG8_STAGE(PG8_SA(0, 1), cA + hstep, voffA);
        if (wr == 1) PG8_BAR;
        PG8_WAIT_V(4); PG8_BAR;
        PG8_STAGE(PG8_SB(1, 0), cB + kstep, voffB); PG8_STAGE(PG8_SA(1, 0), cA + kstep, voffA); PG8_STAGE(PG8_SB(1, 1), cB + hstep + kstep, voffB);
        PG8_WAIT_V(6); PG8_BAR;
    }
    for (;;) {
        const bool has_next = S.next(ui + 1, nxt);
        const char* nA = has_next ? (const char*)g.A + (size_t)nxt.pm * tstep : cA; const char* nB = has_next ? (const char*)g.Bt + (size_t)nxt.pn * tstep : cB;
        for (int t = 0; t < nt; t += 2) {
            const bool last = (t == nt - 2);
            const char* a1 = cA + (size_t)(t + 1) * kstep;
            const char* a2 = last ? nA : cA + (size_t)(t + 2) * kstep; const char* b2 = last ? nB : cB + (size_t)(t + 2) * kstep;
            const char* a3 = a2 + kstep; const char* b3 = b2 + kstep;
            if (last && has_next) S.a_ready(nxt);
            if constexpr (SP2) {
            PG8_LDB(B0, 0, 0); PG8_LDB(B1, 0, 1); PG8_SCHED; PG8_LDA(At, 0, 0); PG8_STAGE(PG8_SA(1, 1), a1 + hstep, voffA);
            PG8_WAIT_V(8); PG8_WAIT_L(0); PG8_BAR; PG8_MMA(0, 0, At, B0); PG8_MMA(0, 1, At, B1); PG8_BAR; PG8_SCHED;
            PG8_LDA(At, 0, 1); PG8_STAGE(PG8_SB(0, 0), b2, voffB); PG8_STAGE(PG8_SB(0, 1), b2 + hstep, voffB); PG8_STAGE(PG8_SA(0, 0), a2, voffA);
            PG8_WAIT_V(8); PG8_WAIT_L(0); PG8_BAR; PG8_MMA(1, 0, At, B0); PG8_MMA(1, 1, At, B1); PG8_BAR; PG8_SCHED;
            PG8_LDB(B0, 1, 0); PG8_LDB(B1, 1, 1); PG8_SCHED; PG8_LDA(At, 1, 0); PG8_STAGE(PG8_SA(0, 1), a2 + hstep, voffA);
            PG8_WAIT_V(8); PG8_WAIT_L(0); PG8_BAR; PG8_MMA(0, 0, At, B0); PG8_MMA(0, 1, At, B1); PG8_BAR; PG8_SCHED;
            PG8_LDA(At, 1, 1); PG8_STAGE(PG8_SB(1, 0), b3, voffB); PG8_STAGE(PG8_SB(1, 1), b3 + hstep, voffB); PG8_STAGE(PG8_SA(1, 0), a3, voffA);
            PG8_WAIT_V(8); PG8_WAIT_L(0); PG8_BAR; PG8_MMA(1, 0, At, B0); PG8_MMA(1, 1, At, B1); PG8_BAR; PG8_SCHED;
            } else {
            PG8_LDB(B0, 0, 0); PG8_SCHED; PG8_LDA(At, 0, 0); PG8_STAGE(PG8_SA(1, 1), a1 + hstep, voffA);
            PG8_WAIT_L(8); PG8_BAR; PG8_WAIT_L(0); PG8_MMA(0, 0, At, B0); PG8_BAR; PG8_SCHED;
            PG8_LDB(B1, 0, 1); PG8_STAGE(PG8_SB(0, 0), b2, voffB);
            PG8_BAR; PG8_WAIT_L(0); PG8_MMA(0, 1, At, B1); PG8_BAR;
            PG8_LDA(At, 0, 1); PG8_STAGE(PG8_SA(0, 0), a2, voffA);
            PG8_BAR; PG8_WAIT_L(0); PG8_MMA(1, 0, At, B0); PG8_BAR; PG8_SCHED;
            PG8_STAGE(PG8_SB(0, 1), b2 + hstep, voffB);
            PG8_WAIT_V(6); PG8_BAR; PG8_MMA(1, 1, At, B1); PG8_BAR;
            PG8_LDB(B0, 1, 0); PG8_SCHED; PG8_LDA(At, 1, 0); PG8_STAGE(PG8_SA(0, 1), a2 + hstep, voffA);
            PG8_WAIT_L(8); PG8_BAR; PG8_WAIT_L(0); PG8_MMA(0, 0, At, B0); PG8_BAR; PG8_SCHED;
            PG8_LDB(B1, 1, 1); PG8_STAGE(PG8_SB(1, 0), b3, voffB);
            PG8_BAR; PG8_WAIT_L(0); PG8_MMA(0, 1, At, B1); PG8_BAR;
            PG8_LDA(At, 1, 1); PG8_STAGE(PG8_SA(1, 0), a3, voffA);
            PG8_BAR; PG8_WAIT_L(0); PG8_MMA(1, 0, At, B0); PG8_BAR; PG8_SCHED;
            PG8_STAGE(PG8_SB(1, 1), b3 + hstep, voffB);
            PG8_WAIT_V(6); PG8_BAR; PG8_MMA(1, 1, At, B1); PG8_BAR;
            }
        }
        if constexpr (ALIGN_EPI) { if (wr == 0) PG8_BAR; }
        if constexpr (!Epi::AFTER_DRAIN) { E(acc, cur, wr, wc, fr, fq); S.done(cur); }
        if (!has_next) break;
#pragma unroll
        for (int a = 0; a < 2; ++a)
#pragma unroll
            for (int b = 0; b < 2; ++b)
#pragma unroll
                for (int m = 0; m < 4; ++m)
#pragma unroll
                    for (int n = 0; n < 2; ++n) acc[a][b][m][n] = (f32x4){0.f, 0.f, 0.f, 0.f};
        cur = nxt; cA = nA; cB = nB; ++ui;
        if constexpr (ALIGN_EPI) { if (wr == 1) PG8_BAR; }
    }
    PG8_WAIT_V(0);
    if constexpr (!ALIGN_EPI) { if (wr == 0) PG8_BAR; }
    PG8_BAR;
    if constexpr (Epi::AFTER_DRAIN) { E.fused(acc, cur, wr, wc, fr, fq, lds, wid, lane); S.done(cur); }
#undef PG8_SA
#undef PG8_SB
#undef PG8_STAGE
#undef PG8_LDA
#undef PG8_LDB
#undef PG8_MMA
#undef PG8_WAIT_V
#undef PG8_WAIT_L
#undef PG8_BAR
#undef PG8_SCHED
}
}

#ifndef PG8_SP2
#define PG8_SP2 true
#endif
#ifndef PG8_ALIGN
#define PG8_ALIGN true
#endif

#include <hip/hip_bf16.h>
#include <cmath>
namespace attn_body {
using bf16=__hip_bfloat16;
using bf16x8=__attribute__((ext_vector_type(8)))short;
using s16x4=__attribute__((ext_vector_type(4)))short;
using f32x16=__attribute__((ext_vector_type(16)))float;
using u32x4=__attribute__((ext_vector_type(4)))unsigned;
constexpr int SEQ=8192,D=64,DM=1024;
constexpr int NW=8,QBLK=32,QB=QBLK*NW,KVBLK=64,NQB=SEQ/QB;
constexpr int ATTN_PITCH=DM, ATTN_UNIT_ROWS=QB;
__device__ __forceinline__ int crow(int r,int hi){return (r&3)+8*(r>>2)+4*hi;}
#define SBAR() __builtin_amdgcn_sched_barrier(0)
__device__ __forceinline__ void cmask(f32x16&p0,f32x16&p1,int jb,int qrel,int hi){
  const float NEG=-INFINITY; int kb=64*jb+4*hi;
  #pragma unroll
  for(int r=0;r<16;++r){int kv=kb+(r&3)+8*(r>>2); if(kv>qrel)p0[r]=NEG; if(kv+32>qrel)p1[r]=NEG;}
}

constexpr int NSLOT=3, SLOTB=8192;
constexpr int LDS_K=0, LDS_V=NSLOT*SLOTB, LDS_WS=2*NSLOT*SLOTB, LDS_OST=LDS_WS+NW*64*4, LDS_BYTES=LDS_OST+NW*4096;
constexpr float C2=0.125f*1.4426950408889634f;
__device__ __forceinline__ void glds16(const void*gsrc,unsigned lds_dst){unsigned keep;
  asm volatile("s_mov_b32 %0, m0\n\ts_mov_b32 m0, %2\n\ts_nop 0\n\tglobal_load_lds_dwordx4 %1, off\n\ts_mov_b32 m0, %0":"=&s"(keep):"v"(gsrc),"s"(lds_dst):"memory");}
__device__ __forceinline__ float max3f(float a,float b,float c){float r;asm("v_max3_f32 %0, %1, %2, %3":"=v"(r):"v"(a),"v"(b),"v"(c));return r;}
__device__ __forceinline__ float max2f(float a,float b){float r;asm("v_max_f32_e32 %0, %1, %2":"=v"(r):"v"(a),"v"(b));return r;}
__device__ __forceinline__ float fadd_s(float a,float b){float r;asm("v_add_f32_e32 %0, %1, %2":"=v"(r):"v"(a),"v"(b));return r;}
__device__ __forceinline__ float fsub_s(float a,float b){float r;asm("v_sub_f32_e32 %0, %1, %2":"=v"(r):"v"(a),"v"(b));return r;}
typedef float f32x2_t __attribute__((ext_vector_type(2))); typedef __bf16 bf16x2_t __attribute__((ext_vector_type(2)));
__device__ __forceinline__ unsigned cvtpk_s(float lo,float hi){f32x2_t v={lo,hi};bf16x2_t b=__builtin_convertvector(v,bf16x2_t);return __builtin_bit_cast(unsigned,b);}
#define WAIT_BAR(N) asm volatile("s_waitcnt vmcnt(" #N ") lgkmcnt(0)\n\ts_barrier":::"memory")

__device__ __forceinline__ void qkt(f32x16&p0,f32x16&p1,const char*Kslot,const bf16x8*qr,const f32x16&negm,int r32,int hi){
  const char*kb=Kslot+hi*1024+r32*16;
  #pragma unroll
  for(int d0=0;d0<4;++d0){
    const bf16x8 b0=*reinterpret_cast<const bf16x8*>(kb+d0*2048);
    const bf16x8 b1=*reinterpret_cast<const bf16x8*>(kb+d0*2048+512);
    if(d0==0){p0=__builtin_amdgcn_mfma_f32_32x32x16_bf16(b0,qr[0],negm,0,0,0);p1=__builtin_amdgcn_mfma_f32_32x32x16_bf16(b1,qr[0],negm,0,0,0);}
    else{p0=__builtin_amdgcn_mfma_f32_32x32x16_bf16(b0,qr[d0],p0,0,0,0);p1=__builtin_amdgcn_mfma_f32_32x32x16_bf16(b1,qr[d0],p1,0,0,0);}}
}
typedef __attribute__((address_space(3))) const char* lds_cptr;
typedef short v4i16_t __attribute__((ext_vector_type(4)));
__device__ __forceinline__ void kload8(bf16x8*kf,lds_cptr kp){
  kf[0]=*(const __attribute__((address_space(3))) bf16x8*)(kp);      kf[1]=*(const __attribute__((address_space(3))) bf16x8*)(kp+512);
  kf[2]=*(const __attribute__((address_space(3))) bf16x8*)(kp+2048); kf[3]=*(const __attribute__((address_space(3))) bf16x8*)(kp+2560);
  kf[4]=*(const __attribute__((address_space(3))) bf16x8*)(kp+4096); kf[5]=*(const __attribute__((address_space(3))) bf16x8*)(kp+4608);
  kf[6]=*(const __attribute__((address_space(3))) bf16x8*)(kp+6144); kf[7]=*(const __attribute__((address_space(3))) bf16x8*)(kp+6656);
}
__device__ __forceinline__ void kload2(bf16x8*kf,lds_cptr kp,int j){ kf[2*j]=*(const __attribute__((address_space(3))) bf16x8*)(kp+j*2048); kf[2*j+1]=*(const __attribute__((address_space(3))) bf16x8*)(kp+j*2048+512); }
__device__ __forceinline__ s16x4 vtr(lds_cptr p){ return __builtin_bit_cast(s16x4,__builtin_amdgcn_ds_read_tr16_b64_v4i16((__attribute__((address_space(3))) v4i16_t*)p)); }
__device__ __forceinline__ float rowmax(const f32x16&p0,const f32x16&p1){
  float a=max3f(p0[0],p0[1],p1[0]),b=max3f(p0[2],p0[3],p1[1]);a=max3f(a,p1[2],p1[3]);
  #pragma unroll
  for(int r=4;r<16;r+=4){a=max3f(a,p0[r],p0[r+1]);b=max3f(b,p0[r+2],p0[r+3]);a=max3f(a,p1[r],p1[r+1]);b=max3f(b,p1[r+2],p1[r+3]);}
  const float m=max2f(a,b);
  auto rr=__builtin_amdgcn_permlane32_swap(__float_as_uint(m),__float_as_uint(m),false,false);
  return max2f(__uint_as_float(rr[0]),__uint_as_float(rr[1]));
}
__device__ __forceinline__ void pv(f32x16*o,int vb,bf16x8 pa0,bf16x8 pa1,bf16x8 pa2,bf16x8 pa3){
  #pragma unroll
  for(int d0=0;d0<2;++d0){s16x4 lo[4],hi[4];
    #pragma unroll
    for(int ks=0;ks<4;++ks){
      asm volatile("ds_read_b64_tr_b16 %0,%1 offset:%c2":"=&v"(lo[ks]):"v"(vb),"i"(d0*4096+ks*1024):"memory");
      asm volatile("ds_read_b64_tr_b16 %0,%1 offset:%c2":"=&v"(hi[ks]):"v"(vb),"i"(d0*4096+ks*1024+512):"memory");}
    asm volatile("s_waitcnt lgkmcnt(0)":::"memory");SBAR();
    #define PK(k) (bf16x8){lo[k][0],lo[k][1],lo[k][2],lo[k][3],hi[k][0],hi[k][1],hi[k][2],hi[k][3]}
    o[d0]=__builtin_amdgcn_mfma_f32_32x32x16_bf16(pa0,PK(0),o[d0],0,0,0);
    o[d0]=__builtin_amdgcn_mfma_f32_32x32x16_bf16(pa1,PK(1),o[d0],0,0,0);
    o[d0]=__builtin_amdgcn_mfma_f32_32x32x16_bf16(pa2,PK(2),o[d0],0,0,0);
    o[d0]=__builtin_amdgcn_mfma_f32_32x32x16_bf16(pa3,PK(3),o[d0],0,0,0);
    #undef PK
  }
}

#ifndef ATTN_STORE16
#define ATTN_STORE16(p,v) (*(u32x4*)(p)=(v))
#endif
template<int THRL> __device__ __forceinline__ void attn_unit(long rowbase,int qcol,int kcol,int vcol,int ocol,int qb,const bf16*Q,const bf16*__restrict__ K,const bf16*__restrict__ V,bf16*O,char*shm){
  const int tid=threadIdx.x,lane=tid&63,r32=lane&31,hi=lane>>5; const int wid=__builtin_amdgcn_readfirstlane(tid>>6);
  const int q0=qb*QB;
  const bf16*Qw=Q+(rowbase+q0+wid*QBLK)*DM+qcol;
  const bf16*Kh=K+rowbase*DM+kcol,*Vh=V+rowbase*DM+vcol;
  const unsigned lds0=(unsigned)(uintptr_t)shm;
  float*wsf=(float*)(shm+LDS_WS)+wid*64;
  const bf16*ksrc=Kh+(long)lane*DM+wid*8;
  const bf16*vsrc=Vh+(long)(16*(wid&3)+(lane>>2))*DM+(wid>>2)*32+(lane&3)*8;
  const unsigned kdst=lds0+LDS_K+wid*1024, vdst=lds0+LDS_V+wid*1024;
  #define DMA_K(t,slot) glds16(ksrc+(long)(t)*KVBLK*DM,(unsigned)__builtin_amdgcn_readfirstlane(kdst+(slot)))
  #define DMA_V(t,slot) glds16(vsrc+(long)(t)*KVBLK*DM,(unsigned)__builtin_amdgcn_readfirstlane(vdst+(slot)))
  const int vb0=(int)(lds0+LDS_V)+((lane>>4)&1)*32+(lane&3)*8+(4*hi+((lane&15)>>2))*64;
  const char*Kbase=shm+LDS_K; bf16x8 kf[8];
  const lds_cptr shm3=(lds_cptr)shm; const lds_cptr kp0=shm3+LDS_K+hi*1024+r32*16; const lds_cptr vp0=shm3+LDS_V+((lane>>4)&1)*32+(lane&3)*8+(4*hi+((lane&15)>>2))*64;
  const int NT=(q0+QB)/KVBLK;
  DMA_K(0,0);DMA_V(0,0);DMA_K(1,SLOTB);
  bf16x8 qr[4];
  #pragma unroll
  for(int d0=0;d0<4;++d0)qr[d0]=*reinterpret_cast<const bf16x8*>(&Qw[(long)r32*DM+d0*16+hi*8]);
  float mhat=0.f,l_reg=0.f;f32x16 o[2];o[0]=f32x16{};o[1]=f32x16{};f32x16 negm=f32x16{};asm volatile("":"+v"(negm));
  const int qrel=wid*QBLK+r32;
  #define CMASK(P0,P1,t) do{int jb_=(t)-(NT-4); if(jb_>=0)cmask(P0,P1,jb_,qrel,hi);}while(0)
  bool resc=false;
  #define START(P0,P1) do{ const float rm=rowmax(P0,P1); resc=false; \
    { const float dl=rm; mhat=fadd_s(mhat,dl); \
      _Pragma("unroll") for(int r=0;r<16;++r){P0[r]=fsub_s(P0[r],dl);P1[r]=fsub_s(P1[r],dl);} \
      _Pragma("unroll") for(int r=0;r<16;++r)negm[r]=-mhat; asm volatile("":"+v"(negm)); } \
    _Pragma("unroll") for(int r=0;r<16;++r)P0[r]=__builtin_amdgcn_exp2f(P0[r]); }while(0)
  #define RESC() do{ if(resc){ asm volatile("s_waitcnt lgkmcnt(0)":::"memory"); \
      _Pragma("unroll") for(int d_=0;d_<2;++d_) _Pragma("unroll") for(int r=0;r<16;++r)o[d_][r]*=wsf[crow(r,hi)]; } }while(0)
  f32x16 pA0,pA1,pB0,pB1;
  int sl_prev=0,sl_cur=0,sl_next=SLOTB;
  #define ROT() do{sl_prev=sl_cur;sl_cur=sl_next;sl_next=(sl_next==(NSLOT-1)*SLOTB)?0:sl_next+SLOTB;}while(0)
  DMA_K(2,2*SLOTB);
  WAIT_BAR(3);
  qkt(pA0,pA1,Kbase,qr,negm,r32,hi);asm volatile("s_nop 15\n\ts_nop 7":"+v"(pA0),"+v"(pA1));CMASK(pA0,pA1,0);
  START(pA0,pA1);
  _Pragma("unroll") for(int r=0;r<16;++r)pA1[r]=__builtin_amdgcn_exp2f(pA1[r]);
  WAIT_BAR(0);
  DMA_K(3,0);DMA_V(1,SLOTB);
  ROT();
  kload8(kf,kp0+sl_cur);
  WAIT_BAR(2);
  s16x4 vlo[8],vhi[8]; u32x4 pw0,pw1,pw2,pw3;
  #define PKW(P,B) cvtpk_s(P[B],P[B+1])
  #define PAF(k) __builtin_bit_cast(bf16x8,pw##k)
  #define VFR(i) (bf16x8){vlo[i][0],vlo[i][1],vlo[i][2],vlo[i][3],vhi[i][0],vhi[i][1],vhi[i][2],vhi[i][3]}
  #define PIN(x) asm volatile("":"+v"(x))
  #define MX3(a,b,c) __builtin_fmaxf(__builtin_fmaxf((a),(b)),(c))
  #define GAPA(MF,A0,A1,A2,A3,W0,W1,PW) do{ MF; sacc+=A0; sacc+=A1; sacc+=A2; sacc+=A3; PIN(sacc); W0; W1; PIN(PW); SBAR(); }while(0)
  #define EX(v) __builtin_amdgcn_exp2f(v)
  #define GAPB(MF,X,B) do{ MF; X[B]=EX(X[B]); X[B+1]=EX(X[B+1]); X[B+2]=EX(X[B+2]); X[B+3]=EX(X[B+3]); PIN(X); SBAR(); }while(0)
  #define VRD(i) do{ vlo[i]=vtr(vp_+(((i)>>2)*4096+((i)&3)*1024)); vhi[i]=vtr(vp_+(((i)>>2)*4096+((i)&3)*1024+512)); }while(0)
  #define KRD(G,j) do{ if(G){ kload2(kf,kp0+sl_next,j); SBAR(); } }while(0)
  #define STEP(C0,C1,P0,P1,t,GK,GV,GL) do{ SBAR(); \
    const lds_cptr vp_=vp0+sl_prev; \
    VRD(0); SBAR(); float sacc=(P0[0]+P0[1]); \
    GAPA(C0=__builtin_amdgcn_mfma_f32_32x32x16_bf16(kf[0],qr[0],negm,0,0,0), P0[2],P0[3],P0[4],P0[5],     pw0[0]=PKW(P0,0), pw0[1]=PKW(P0,2), pw0); \
    VRD(4); SBAR(); GAPA(C1=__builtin_amdgcn_mfma_f32_32x32x16_bf16(kf[1],qr[0],negm,0,0,0), P0[6],P0[7],P0[8],P0[9],     pw0[2]=PKW(P0,4), pw0[3]=PKW(P0,6), pw0); \
    VRD(1); SBAR(); GAPA(C0=__builtin_amdgcn_mfma_f32_32x32x16_bf16(kf[2],qr[1],C0,0,0,0),   P0[10],P0[11],P0[12],P0[13], pw1[0]=PKW(P0,8), pw1[1]=PKW(P0,10), pw1); \
    VRD(5); SBAR(); GAPA(C1=__builtin_amdgcn_mfma_f32_32x32x16_bf16(kf[3],qr[1],C1,0,0,0),   P0[14],P0[15],P1[0],P1[1],   pw1[2]=PKW(P0,12),pw1[3]=PKW(P0,14), pw1); \
    VRD(2); SBAR(); GAPA(C0=__builtin_amdgcn_mfma_f32_32x32x16_bf16(kf[4],qr[2],C0,0,0,0),   P1[2],P1[3],P1[4],P1[5],     pw2[0]=PKW(P1,0), pw2[1]=PKW(P1,2), pw2); \
    VRD(6); SBAR(); GAPA(C1=__builtin_amdgcn_mfma_f32_32x32x16_bf16(kf[5],qr[2],C1,0,0,0),   P1[6],P1[7],P1[8],P1[9],     pw2[2]=PKW(P1,4), pw2[3]=PKW(P1,6), pw2); \
    VRD(3); SBAR(); GAPA(C0=__builtin_amdgcn_mfma_f32_32x32x16_bf16(kf[6],qr[3],C0,0,0,0),   P1[10],P1[11],P1[12],P1[13], pw3[0]=PKW(P1,8), pw3[1]=PKW(P1,10), pw3); \
    VRD(7); SBAR(); GAPA(C1=__builtin_amdgcn_mfma_f32_32x32x16_bf16(kf[7],qr[3],C1,0,0,0),   P1[14],P1[15],0.f,0.f,       pw3[2]=PKW(P1,12),pw3[3]=PKW(P1,14), pw3); \
    l_reg+=sacc; \
    if(GK){DMA_K((t)+3,sl_cur);} if(GV){DMA_V((t)+1,sl_next);} \
    CMASK(C0,C1,t); \
    { float a=MX3(C0[0],C0[1],C1[0]),b=MX3(C0[2],C0[3],C1[1]); a=MX3(a,C1[2],C1[3]); \
      _Pragma("unroll") for(int r=4;r<16;r+=4){a=MX3(a,C0[r],C0[r+1]);b=MX3(b,C0[r+2],C0[r+3]);a=MX3(a,C1[r],C1[r+1]);b=MX3(b,C1[r+2],C1[r+3]);} \
      float rm=__builtin_fmaxf(a,b); { auto rr=__builtin_amdgcn_permlane32_swap(__float_as_uint(rm),__float_as_uint(rm),false,false); rm=__builtin_fmaxf(__uint_as_float(rr[0]),__uint_as_float(rr[1])); } \
      resc=false; \
      if(__builtin_expect(__any(rm>(float)THRL),0)){ const float dl=__builtin_fmaxf(rm,0.f); mhat+=dl; \
        _Pragma("unroll") for(int r=0;r<16;++r){C0[r]-=dl;C1[r]-=dl;} \
        _Pragma("unroll") for(int r=0;r<16;++r)negm[r]=-mhat; asm volatile("":"+v"(negm)); \
        const float f=__builtin_amdgcn_exp2f(-dl); l_reg*=f; if(hi==0)wsf[r32]=f; resc=true; } } \
    SBAR(); \
    GAPB(o[0]=__builtin_amdgcn_mfma_f32_32x32x16_bf16(PAF(0),VFR(0),o[0],0,0,0), C0,0); \
    GAPB(o[1]=__builtin_amdgcn_mfma_f32_32x32x16_bf16(PAF(0),VFR(4),o[1],0,0,0), C0,4); \
    KRD(GL,0); GAPB(o[0]=__builtin_amdgcn_mfma_f32_32x32x16_bf16(PAF(1),VFR(1),o[0],0,0,0), C0,8); \
    KRD(GL,1); GAPB(o[1]=__builtin_amdgcn_mfma_f32_32x32x16_bf16(PAF(1),VFR(5),o[1],0,0,0), C0,12); \
    KRD(GL,2); GAPB(o[0]=__builtin_amdgcn_mfma_f32_32x32x16_bf16(PAF(2),VFR(2),o[0],0,0,0), C1,0); \
    KRD(GL,3); GAPB(o[1]=__builtin_amdgcn_mfma_f32_32x32x16_bf16(PAF(2),VFR(6),o[1],0,0,0), C1,4); \
    GAPB(o[0]=__builtin_amdgcn_mfma_f32_32x32x16_bf16(PAF(3),VFR(3),o[0],0,0,0), C1,8); \
    GAPB(o[1]=__builtin_amdgcn_mfma_f32_32x32x16_bf16(PAF(3),VFR(7),o[1],0,0,0), C1,12); \
    }while(0)
  int t=1;
  #undef CMASK
  #define CMASK(P0,P1,t) do{}while(0)
  for(;t+5<NT;t+=2){
    STEP(pB0,pB1,pA0,pA1,t,true,true,true);     WAIT_BAR(2); RESC(); ROT();
    STEP(pA0,pA1,pB0,pB1,t+1,true,true,true);   WAIT_BAR(2); RESC(); ROT();
  }
  #undef CMASK
  #define CMASK(P0,P1,t) do{int jb_=(t)-(NT-4); if(jb_>=0)cmask(P0,P1,jb_,qrel,hi);}while(0)
  #define ENDW(tt) do{ if((tt)+3<NT){WAIT_BAR(2);} else if((tt)+2<NT){WAIT_BAR(1);} else {WAIT_BAR(0);} }while(0)
  for(;t+1<NT;t+=2){
    STEP(pB0,pB1,pA0,pA1,t,(t+3<NT),(t+1<NT),(t+1<NT));       ENDW(t);   RESC(); ROT();
    STEP(pA0,pA1,pB0,pB1,t+1,(t+4<NT),(t+2<NT),(t+2<NT));     ENDW(t+1); RESC(); ROT();
  }
  STEP(pB0,pB1,pA0,pA1,NT-1,false,false,false); RESC();
  { float sacc=pB0[0]+pB0[1]; _Pragma("unroll") for(int r=2;r<16;++r)sacc+=pB0[r]; _Pragma("unroll") for(int r=0;r<16;++r)sacc+=pB1[r]; l_reg+=sacc;
    pw0=(u32x4){PKW(pB0,0),PKW(pB0,2),PKW(pB0,4),PKW(pB0,6)};pw1=(u32x4){PKW(pB0,8),PKW(pB0,10),PKW(pB0,12),PKW(pB0,14)};pw2=(u32x4){PKW(pB1,0),PKW(pB1,2),PKW(pB1,4),PKW(pB1,6)};pw3=(u32x4){PKW(pB1,8),PKW(pB1,10),PKW(pB1,12),PKW(pB1,14)};
    SBAR(); pv(o,vb0+sl_cur,PAF(0),PAF(1),PAF(2),PAF(3)); }
  #undef PKW
  #undef PAF
  #undef VFR
  #undef PIN
  #undef MX3
  #undef GAPA
  #undef GAPB
  #undef EX
  #undef VRD
  #undef KRD
  #undef STEP
  #undef ENDW
  {auto rr=__builtin_amdgcn_permlane32_swap(__float_as_uint(l_reg),__float_as_uint(l_reg),false,false);l_reg=__uint_as_float(rr[0])+__uint_as_float(rr[1]);}
  if(hi==0)wsf[32+r32]=l_reg;asm volatile("s_waitcnt lgkmcnt(0)":::"memory");
  float rli[16];
  #pragma unroll
  for(int r=0;r<16;++r)rli[r]=__builtin_amdgcn_rcpf(wsf[32+crow(r,hi)]);
  bf16*Ow=O+(rowbase+q0+wid*QBLK)*DM+ocol;
  { bf16*stg=(bf16*)(shm+LDS_OST)+wid*2048;
    #pragma unroll
    for(int r=0;r<16;++r){const int orow=crow(r,hi);
      #pragma unroll
      for(int d0=0;d0<2;++d0)stg[orow*64+d0*32+r32]=__float2bfloat16(o[d0][r]*rli[r]);}
    asm volatile("s_waitcnt lgkmcnt(0)":::"memory");
    #pragma unroll
    for(int i=0;i<4;++i){const int row=i*8+(lane>>3),ch=lane&7; const u32x4 v=*(const u32x4*)(stg+row*64+ch*8); ATTN_STORE16(Ow+(long)row*DM+ch*8,v);} }
  asm volatile("s_waitcnt lgkmcnt(0)\n\ts_barrier":::"memory");
  #undef DMA_K
  #undef DMA_V
  #undef CMASK
  #undef START
  #undef RESC
  #undef ROT
}
constexpr int ATTN_LDS_BYTES=LDS_BYTES;
struct AttnTensors { const bf16* Q; const bf16* K; const bf16* V; bf16* O1; bf16* O2; };
struct AttnUnit { int b, mh, vo, s, qb; };
struct DealOrder {
  int vcu;
  __device__ __forceinline__ explicit DealOrder(int v):vcu(v){}
  __device__ __forceinline__ bool next(int i,AttnUnit&u)const{ if(i>=16)return false; const int bh=vcu>>3,h=bh&7,sub=vcu&7,s=sub>>2,vh=(sub>>1)&1,par=sub&1,j=par+2*(i>>1);
    u.b=bh>>3; u.mh=(s*8+h)*64; u.vo=h*128+vh*64; u.s=s; u.qb=(i&1)?31-j:j; return true; }
};
template<class Sched,int THRL=8> __device__ __forceinline__ void attn_phase(char*lds,const AttnTensors&T,const Sched&S){
  AttnUnit u;
  for(int i=0;S.next(i,u);++i){ attn_unit<THRL>((long)u.b*SEQ,u.mh,u.mh,u.vo,u.vo,u.qb,T.Q,T.K,T.V,u.s?T.O2:T.O1,lds); }
}
#undef SBAR
#undef WAIT_BAR
}

#define GAS __attribute__((address_space(1)))
#define LAS __attribute__((address_space(3)))
typedef unsigned v4u __attribute__((ext_vector_type(4)));
typedef float f32x4 __attribute__((ext_vector_type(4)));
typedef short bf16x8 __attribute__((ext_vector_type(8)));
typedef GAS unsigned gu32;
typedef GAS unsigned long long gu64;
#define RLX_AGENT __ATOMIC_RELAXED, __HIP_MEMORY_SCOPE_AGENT
#define LDS_WAIT() asm volatile("s_waitcnt lgkmcnt(0)" ::: "memory")
#define VM_WAIT() asm volatile("s_waitcnt vmcnt(0)" ::: "memory")
__device__ __forceinline__ unsigned long long rt() { return __builtin_amdgcn_s_memrealtime(); }

#define XB_TMO      128
#define XB_XCNT(j)  (256  + 64 * (j))
#define XB_XSUB(j)  (1280 + 64 * (j))
#define XB_XGEN(j)  (2304 + 64 * (j))
#define XB_TOP      3328
#define XB_TOPGEN   3392
#define XCD_BAR_WORDS 3456
#define XB_SPIN_CAP (1u << 18)

__device__ __forceinline__ unsigned xb_ld(unsigned* p)              { return __hip_atomic_load(p, __ATOMIC_RELAXED, __HIP_MEMORY_SCOPE_AGENT); }
__device__ __forceinline__ unsigned xb_add(unsigned* p, unsigned v) { return __hip_atomic_fetch_add(p, v, __ATOMIC_RELAXED, __HIP_MEMORY_SCOPE_AGENT); }
__device__ __forceinline__ unsigned xb_xcc_id() { return (unsigned)__builtin_amdgcn_s_getreg((3 << 11) | 20) & 0xFu; }
#define XB_SPIN(cond, bar) do { unsigned _sp = 0; while (cond) { __builtin_amdgcn_s_sleep(1); \
    if ((++_sp & 255u) == 0u) { if (xb_ld(&(bar)[XB_TMO])) break; if (_sp > XB_SPIN_CAP) { atomicAdd(&(bar)[XB_TMO], 1u); break; } } } } while (0)

struct XcdBarrier {
    unsigned* bar; unsigned x;
    volatile LAS unsigned* st;
};

__device__ __forceinline__ XcdBarrier xcd_barrier_post(unsigned* bar, volatile LAS unsigned* st) {
    XcdBarrier b; b.bar = bar; b.x = xb_xcc_id(); b.st = st;
    if (threadIdx.x == 0) (void)xb_add(&bar[XB_XCNT(b.x)], 1u);
    return b;
}
__device__ __forceinline__ void xcd_barrier_complete(unsigned* bar, unsigned x, unsigned& nloc, unsigned& nx) {
    const unsigned G = gridDim.x * gridDim.y * gridDim.z;
    unsigned sum, cnt, mine, sp = 0u;
    for (;;) {
        sum = 0u; cnt = 0u; mine = 0u;
#pragma unroll
        for (unsigned j = 0; j < 16; ++j) { const unsigned c = xb_ld(&bar[XB_XCNT(j)]); sum += c; cnt += (c > 0u) ? 1u : 0u; mine = (j == x) ? c : mine; }
        if (sum == G) break;
        __builtin_amdgcn_s_sleep(1);
        if ((++sp & 255u) == 0u) { if (xb_ld(&bar[XB_TMO])) break; if (sp > XB_SPIN_CAP) { atomicAdd(&bar[XB_TMO], 1u); break; } }
    }
    nloc = mine > 0u ? mine : 1u; nx = cnt > 0u ? cnt : 1u;
}

__device__ __forceinline__ void xcd_barrier(const XcdBarrier& b) {
    asm volatile("s_waitcnt vmcnt(0)" ::: "memory");
    __syncthreads();
    if (threadIdx.x == 0) {
        unsigned* bar = b.bar;
        __builtin_amdgcn_s_waitcnt(0);
        unsigned nloc = b.st[0], nx = b.st[1];
        if (nloc == 0u) { xcd_barrier_complete(bar, b.x, nloc, nx); b.st[0] = nloc; b.st[1] = nx; }
        const unsigned old = xb_add(&bar[XB_XSUB(b.x)], 1u);
        const unsigned gen = old / nloc;
        if (old + 1u == (gen + 1u) * nloc) {
            __builtin_amdgcn_fence(__ATOMIC_RELEASE, "agent");
            asm volatile("s_waitcnt vmcnt(0)" ::: "memory");
            const unsigned og = xb_add(&bar[XB_TOP], 1u);
            const unsigned tg = og / nx;
            if (og + 1u == (tg + 1u) * nx) xb_add(&bar[XB_TOPGEN], 1u);
            else XB_SPIN(xb_ld(&bar[XB_TOPGEN]) == tg, bar);
            __builtin_amdgcn_fence(__ATOMIC_ACQUIRE, "agent");
            xb_add(&bar[XB_XGEN(b.x)], 1u);
            asm volatile("s_waitcnt vmcnt(0)" ::: "memory");
        } else {
            XB_SPIN(xb_ld(&bar[XB_XGEN(b.x)]) == gen, bar);
            __builtin_amdgcn_fence(__ATOMIC_ACQUIRE, "agent");
            asm volatile("s_waitcnt vmcnt(0)" ::: "memory");
        }
    }
    __syncthreads();
}

namespace pg8 {
__device__ __forceinline__ float fast_sigmoid(float v) { return __builtin_amdgcn_rcpf(1.0f + __builtin_amdgcn_exp2f(-1.4426950408889634f * v)); }
__device__ __forceinline__ void st8(bf16_t* p, const f32x4& v0, const f32x4& v1) {
    u32x4 w; w.x = cvt_pk_bf16(v0[0], v0[1]); w.y = cvt_pk_bf16(v0[2], v0[3]); w.z = cvt_pk_bf16(v1[0], v1[1]); w.w = cvt_pk_bf16(v1[2], v1[3]); *(u32x4*)p = w; }
struct EpiProj {
    static constexpr bool PERM = true, AFTER_DRAIN = false;
    bf16_t *U, *Q, *Kb, *V, *GC, *GA; const float* rope;
    __device__ __forceinline__ void operator()(const f32x4 (&acc)[2][2][4][2], const Unit& u, int wr, int wc, int fr, int fq) const {
        const int row0 = u.pm * BM + wr * 64 + fr, pn = u.pn;
        if (pn < 8) {
            const int col = 128 * pn + 32 * wc + 8 * fq;
#pragma unroll
            for (int ai = 0; ai < 2; ++ai)
#pragma unroll
                for (int m = 0; m < 4; ++m) { f32x4 o[2];
#pragma unroll
                    for (int n = 0; n < 2; ++n)
#pragma unroll
                        for (int i = 0; i < 4; ++i) o[n][i] = acc[ai][0][m][n][i] * fast_sigmoid(acc[ai][1][m][n][i]);
                    st8(U + (size_t)(row0 + ai * HALF + m * 16) * 1024 + col, o[0], o[1]); }
        } else if (pn < 16) {
            const int qk = (pn - 8) >> 2, head = 4 * ((pn - 8) & 3) + wc, d0 = 8 * fq;
            bf16_t* P = qk ? Kb : Q; const float sc = qk ? 1.0f : 0.18033688011112042f;
#pragma unroll
            for (int ai = 0; ai < 2; ++ai)
#pragma unroll
                for (int m = 0; m < 4; ++m) { const int row = row0 + ai * HALF + m * 16; const float* rp = rope + ((size_t)(row & 8191) * 32 + d0) * 2;
                    f32x4 o1[2], o2[2];
#pragma unroll
                    for (int n = 0; n < 2; ++n) { const f32x4 cs0 = *(const f32x4*)(rp + 8 * n), cs1 = *(const f32x4*)(rp + 8 * n + 4);
                        const float cc[4] = {cs0[0], cs0[2], cs1[0], cs1[2]}, ss[4] = {cs0[1], cs0[3], cs1[1], cs1[3]};
#pragma unroll
                        for (int i = 0; i < 4; ++i) { const float x1 = acc[ai][0][m][n][i], x2 = acc[ai][1][m][n][i];
                            o1[n][i] = (x1 * cc[i] - x2 * ss[i]) * sc; o2[n][i] = (x2 * cc[i] + x1 * ss[i]) * sc; } }
                    bf16_t* rowp = P + (size_t)row * 1024 + head * 64 + d0; st8(rowp, o1[0], o1[1]); st8(rowp + 32, o2[0], o2[1]); }
        } else if (pn < 20) {
            const int col = 256 * (pn - 16) + 32 * wc + 8 * fq;
#pragma unroll
            for (int ai = 0; ai < 2; ++ai)
#pragma unroll
                for (int m = 0; m < 4; ++m)
#pragma unroll
                    for (int bj = 0; bj < 2; ++bj) st8(V + (size_t)(row0 + ai * HALF + m * 16) * 1024 + col + bj * HALF, acc[ai][bj][m][0], acc[ai][bj][m][1]);
        } else {
            bf16_t* P = (pn >= 24) ? GA : GC; const int col = 256 * ((pn - 20) & 3) + 32 * wc + 8 * fq;
#pragma unroll
            for (int ai = 0; ai < 2; ++ai)
#pragma unroll
                for (int m = 0; m < 4; ++m)
#pragma unroll
                    for (int bj = 0; bj < 2; ++bj) { f32x4 o[2];
#pragma unroll
                        for (int n = 0; n < 2; ++n)
#pragma unroll
                            for (int i = 0; i < 4; ++i) o[n][i] = fast_sigmoid(acc[ai][bj][m][n][i]);
                        st8(P + (size_t)(row0 + ai * HALF + m * 16) * 1024 + col + bj * HALF, o[0], o[1]); }
        }
    }
};
template <int MODE> struct EpiPlain {
    static constexpr bool PERM = true, AFTER_DRAIN = false;
    bf16_t* O; int ldc; const float* bias; const bf16_t* G;
    __device__ __forceinline__ void operator()(const f32x4 (&acc)[2][2][4][2], const Unit& u, int wr, int wc, int fr, int fq) const {
        const int row0 = u.pm * BM + wr * 64 + fr, col0 = u.pn * BM + wc * 32 + 8 * fq;
        f32x4 bv[2][2];
        if (MODE == 1) {
#pragma unroll
            for (int bj = 0; bj < 2; ++bj)
#pragma unroll
                for (int n = 0; n < 2; ++n) bv[bj][n] = *(const f32x4*)(bias + col0 + bj * HALF + 4 * n); }
#pragma unroll
        for (int ai = 0; ai < 2; ++ai)
#pragma unroll
            for (int m = 0; m < 4; ++m) { const size_t off = (size_t)(row0 + ai * HALF + m * 16) * ldc + col0;
#pragma unroll
                for (int bj = 0; bj < 2; ++bj) { f32x4 v0 = acc[ai][bj][m][0], v1 = acc[ai][bj][m][1];
                    if (MODE == 1) { const u32x4 g = *(const u32x4*)(G + off + bj * HALF);
                        v0 = v0 + bv[bj][0]; v1 = v1 + bv[bj][1];
                        v0[0] *= __uint_as_float(g.x << 16); v0[1] *= __uint_as_float(g.x & 0xffff0000u); v0[2] *= __uint_as_float(g.y << 16); v0[3] *= __uint_as_float(g.y & 0xffff0000u);
                        v1[0] *= __uint_as_float(g.z << 16); v1[1] *= __uint_as_float(g.z & 0xffff0000u); v1[2] *= __uint_as_float(g.w << 16); v1[3] *= __uint_as_float(g.w & 0xffff0000u); }
                    if (MODE == 2) {
#pragma unroll
                        for (int i = 0; i < 4; ++i) { const float a = __builtin_fmaxf(v0[i], 0.f), b = __builtin_fmaxf(v1[i], 0.f); v0[i] = a * a; v1[i] = b * b; } }
                    st8(O + off + bj * HALF, v0, v1); } }
    }
};
}

constexpr int NWAVES = 8;
typedef unsigned v2u __attribute__((ext_vector_type(2)));
constexpr size_t WS_WIN = 2 * MiB, WS_WC = 16 * MiB, WS_WO = 18 * MiB, WS_W1 = 20 * MiB, WS_W2 = 28 * MiB, WS_ROPET = 36 * MiB;
constexpr int CW_BAR = 4096;
constexpr size_t CTL_ZERO_BYTES = 1 * MiB;
constexpr int RING_OFF = 0, RING_BYTES = 131072;
constexpr int LDSCTL_OFF = RING_BYTES, MISC_OFF = LDSCTL_OFF + 320;
constexpr int LDS_BYTES = 147456;

struct Frame {
    LAS unsigned char* lds; volatile LAS unsigned* MISC;
    int tid, lane, wave, vcu, G;
};
__device__ __forceinline__ float wave_sum(float v) {
#pragma unroll
    for (int o = 1; o < 64; o <<= 1) v += __shfl_xor(v, o);
    return v;
}
__device__ __forceinline__ f32x4 bf4(unsigned lo, unsigned hi) { return (f32x4){__uint_as_float(lo << 16), __uint_as_float(lo & 0xffff0000u), __uint_as_float(hi << 16), __uint_as_float(hi & 0xffff0000u)}; }
__device__ __forceinline__ float gload_f32(const float* p) { return __uint_as_float(__hip_atomic_load((const unsigned*)p, __ATOMIC_RELAXED, __HIP_MEMORY_SCOPE_AGENT)); }

__device__ __forceinline__ int win_vrow(int n0) {
    if (n0 < 1024) return 256 * (n0 >> 7) + (n0 & 127);
    if (n0 < 2048) { const int n = n0 - 1024; return 256 * (n >> 7) + 128 + (n & 127); }
    if (n0 < 4096) { const int n = (n0 - 2048) & 1023, base = 2048 + ((n0 - 2048) & ~1023), head = n >> 6, half = (n >> 5) & 1; return base + 256 * (head >> 2) + 128 * half + 32 * (head & 3); }
    return n0;
}
template <bool PERMUTE> __device__ __forceinline__ void p0_transpose_item(const float* W, int K, int N, bf16* WT, LAS float* scr, int item, int lane) {
    const int nblk = N / 32, kb = item / nblk, nb = item % nblk, k0 = 64 * kb, n0 = 32 * nb;
    const int vr = PERMUTE ? win_vrow(n0) : n0;
#pragma unroll 8
    for (int i = 0; i < 32; ++i) { const int kk = 2 * i + (lane >> 5); scr[kk * 33 + (lane & 31)] = W[(size_t)(k0 + kk) * N + n0 + (lane & 31)]; }
    LDS_WAIT(); asm volatile("" ::: "memory");
    const int c = lane & 7;
#pragma unroll
    for (int j = 0; j < 4; ++j) { const int n = (lane >> 3) + 8 * j; const LAS float* s = scr + (8 * c) * 33 + n;
        v4u o; o.x = pk2(s[0 * 33], s[1 * 33]); o.y = pk2(s[2 * 33], s[3 * 33]); o.z = pk2(s[4 * 33], s[5 * 33]); o.w = pk2(s[6 * 33], s[7 * 33]);
        *(GAS v4u*)(WT + (size_t)(vr + n) * K + k0 + 8 * c) = o; }
    LDS_WAIT(); asm volatile("" ::: "memory");
}
__device__ __forceinline__ void sincos_d(double a, float& s, float& c) {
    const double k = __builtin_rint(a * 0.6366197723675814);
    double y = __builtin_fma(-k, 1.5707963267948966, a); y = __builtin_fma(-k, 6.123233995736766e-17, y);
    const double y2 = y * y;
    double sp = 1.0 / 6227020800.0; sp = sp * y2 - 1.0 / 39916800.0; sp = sp * y2 + 1.0 / 362880.0; sp = sp * y2 - 1.0 / 5040.0; sp = sp * y2 + 1.0 / 120.0; sp = sp * y2 - 1.0 / 6.0; sp = sp * y2 * y + y;
    double cp = 1.0 / 479001600.0; cp = cp * y2 - 1.0 / 3628800.0; cp = cp * y2 + 1.0 / 40320.0; cp = cp * y2 - 1.0 / 720.0; cp = cp * y2 + 1.0 / 24.0; cp = cp * y2 - 0.5; cp = cp * y2 + 1.0;
    const int q = ((int)k) & 3;
    const double sv = (q & 1) ? cp : sp, cv = (q & 1) ? sp : cp;
    s = (float)((q & 2) ? -sv : sv); c = (float)(((q + 1) & 2) ? -cv : cv);
}

struct Ptrs {
    const float *x, *c, *w_ada, *b_ada, *pre1, *post1, *w_in, *conv_w, *conv_b, *ln_g, *ln_b, *wc_out, *bc_out, *lq1, *lk1, *lq2, *lk2, *hn, *w_o, *pre2, *post2, *w1, *w2;
    float *out, *mod, *rope;
    bf16 *WIN, *WC, *WO, *W1, *W2, *R[7];
};

__device__ __forceinline__ void p0_prologue(Frame& F, const Ptrs& P) {
    {
        LAS float* red = (LAS float*)(F.lds + RING_OFF);
        const int j = F.tid & 31, kg = F.tid >> 5;
        for (int cb = F.vcu; cb < 256; cb += F.G) {
            const int col = cb * 24 + j; float a0 = 0.f, a1 = 0.f, a2 = 0.f, a3 = 0.f;
            if (j < 24) for (int k = kg * 64; k < kg * 64 + 64; ++k) { const float w = P.w_ada[(size_t)k * 6144 + col];
                const float c0 = P.c[k], c1 = P.c[1024 + k], c2 = P.c[2048 + k], c3 = P.c[3072 + k];
                a0 += c0 * sigmoidf_(c0) * w; a1 += c1 * sigmoidf_(c1) * w; a2 += c2 * sigmoidf_(c2) * w; a3 += c3 * sigmoidf_(c3) * w; }
            red[(kg * 4 + 0) * 32 + j] = a0; red[(kg * 4 + 1) * 32 + j] = a1; red[(kg * 4 + 2) * 32 + j] = a2; red[(kg * 4 + 3) * 32 + j] = a3;
            __syncthreads();
            if (F.tid < 128 && j < 24) { const int b = F.tid >> 5; float s = 0.f;
#pragma unroll
                for (int g = 0; g < 16; ++g) s += red[(g * 4 + b) * 32 + j];
                P.mod[b * 6144 + col] = s + P.b_ada[col]; }
            __syncthreads();
        }
        if (blockIdx.x == 0 && F.tid == 0) { float s1 = 0.f, s2 = 0.f;
            for (int i = 0; i < 64; ++i) { s1 += P.lq1[i] * P.lk1[i]; s2 += P.lq2[i] * P.lk2[i]; }
            P.mod[4 * 6144] = __expf(s1) - __expf(s2) + LAM_INIT; }
    }
    {
        const int gt = F.vcu * (NWAVES * 64) + F.tid, NT_ = F.G * NWAVES * 64;
        for (int e = gt; e < T * 32; e += NT_) { const int t = e >> 5, d = e & 31; double invf = 1.0;
            for (int i = 0; i < d; ++i) invf *= 0.7498942093324559;
            float s, c; sincos_d((double)t * invf, s, c); *(float2*)(P.rope + 2 * (size_t)e) = make_float2(c, s); }
    }
    {
        LAS float* scr = (LAS float*)(F.lds + RING_OFF + F.wave * 16384);
        const int gw = F.vcu * NWAVES + F.wave, NGW = F.G * NWAVES;
        constexpr int I_IN = (D / 64) * (DIN / 32), I_C = (D / 64) * (D / 32), I_O = I_C, I_1 = (D / 64) * (FF / 32), I_2 = (FF / 64) * (D / 32);
        constexpr int NITEMS = I_IN + I_C + I_O + I_1 + I_2;
        for (int it = gw; it < NITEMS; it += NGW) {
            int r = it;
            if (r < I_IN) { p0_transpose_item<true>(P.w_in, D, DIN, P.WIN, scr, r, F.lane); continue; } r -= I_IN;
            if (r < I_C) { p0_transpose_item<false>(P.wc_out, D, D, P.WC, scr, r, F.lane); continue; } r -= I_C;
            if (r < I_O) { p0_transpose_item<false>(P.w_o, D, D, P.WO, scr, r, F.lane); continue; } r -= I_O;
            if (r < I_1) { p0_transpose_item<false>(P.w1, D, FF, P.W1, scr, r, F.lane); continue; } r -= I_1;
            p0_transpose_item<false>(P.w2, FF, D, P.W2, scr, r, F.lane);
        }
    }
}
__device__ __forceinline__ void p1_h1(Frame& F, const Ptrs& P, bf16* XN) {
    const int gw = F.vcu * NWAVES + F.wave, NGW = F.G * NWAVES;
    for (int b = 0; b < BATCH; ++b) {
        const float* mb = P.mod + b * 6144; f32x4 A[4], Bv[4];
#pragma unroll
        for (int j = 0; j < 4; ++j) { const int c = 4 * F.lane + 256 * j; A[j] = *(const f32x4*)(P.pre1 + c) * (*(const f32x4*)(mb + 1024 + c) + 1.0f); Bv[j] = *(const f32x4*)(mb + c); }
        for (int r = gw; r < T; r += NGW) { const size_t row = (size_t)b * T + r;
            const GAS f32x4* xr = (const GAS f32x4*)(P.x + row * D) + F.lane; f32x4 v[4]; float s = 0.f;
#pragma unroll
            for (int j = 0; j < 4; ++j) { v[j] = xr[64 * j]; s += (v[j].x * v[j].x + v[j].y * v[j].y) + (v[j].z * v[j].z + v[j].w * v[j].w); }
            const float rstd = rsqrtf(wave_sum(s) * (1.f / D) + EPS);
            GAS unsigned long long* o8 = (GAS unsigned long long*)(XN + row * D) + F.lane;
#pragma unroll
            for (int j = 0; j < 4; ++j) { const f32x4 o = v[j] * rstd * A[j] + Bv[j]; o8[64 * j] = (unsigned long long)pk2(o.x, o.y) | ((unsigned long long)pk2(o.z, o.w) << 32); } }
    }
}
__device__ __forceinline__ void p3_conv(Frame& F, const Ptrs& P, const bf16* U, bf16* UC) {
    LAS unsigned char* lds = F.lds + RING_OFF;
    LAS float* P1 = (LAS float*)(lds + 62 * 2048); LAS float* P2 = P1 + 128;
    const int cq = F.wave & 3, th = F.wave >> 2, ch0 = cq * 256 + 4 * F.lane;
    const f32x4 cb = *(const f32x4*)(P.conv_b + ch0);
    for (int tile = F.vcu; tile < M / 32; tile += F.G) {
        const int row0 = tile * 32, t0 = row0 & (T - 1);
        for (int i = F.tid; i < 62 * 128; i += NWAVES * 64) { const int r = i >> 7, c16 = i & 127; v4u val = {0u, 0u, 0u, 0u};
            if (t0 - 30 + r >= 0) val = *(const GAS v4u*)(U + (size_t)(row0 - 30 + r) * D + c16 * 8);
            *(LAS v4u*)(lds + r * 2048 + c16 * 16) = val; }
        __syncthreads();
        f32x4 acc[16];
#pragma unroll
        for (int k = 0; k < 16; ++k) acc[k] = cb;
#pragma unroll 1
        for (int tb = 0; tb < 4; ++tb) {
            f32x4 w[8];
#pragma unroll
            for (int i = 0; i < 8; ++i) { const int tap = 8 * tb + i; w[i] = *(const f32x4*)(P.conv_w + (size_t)(tap < CWID ? tap : 0) * D + ch0); if (tap >= CWID) w[i] = (f32x4){0.f, 0.f, 0.f, 0.f}; }
            const LAS unsigned char* base = lds + (th * 16 + 8 * tb) * 2048 + ch0 * 2;
#pragma unroll
            for (int r = 0; r < 23; ++r) { v2u raw = *(const LAS v2u*)(base + r * 2048); if (r == 22 && tb == 3) raw = (v2u){0u, 0u};
                const f32x4 u = bf4(raw.x, raw.y);
#pragma unroll
                for (int k = 0; k < 16; ++k) { const int tl = r - k; if (tl >= 0 && tl < 8) acc[k] += u * w[tl]; } }
        }
#pragma unroll
        for (int k = 0; k < 16; ++k) { const float s = wave_sum((acc[k].x + acc[k].y) + (acc[k].z + acc[k].w)); if (F.lane == 0) P1[(th * 16 + k) * 4 + cq] = s; }
        __syncthreads();
#pragma unroll
        for (int k = 0; k < 16; ++k) { const f32x4 p = *(const LAS f32x4*)(P1 + (th * 16 + k) * 4); const float mean = ((p.x + p.y) + (p.z + p.w)) * (1.f / D);
            acc[k] = acc[k] - mean; const f32x4 a = acc[k]; const float q = wave_sum((a.x * a.x + a.y * a.y) + (a.z * a.z + a.w * a.w)); if (F.lane == 0) P2[(th * 16 + k) * 4 + cq] = q; }
        __syncthreads();
        const f32x4 lg = *(const f32x4*)(P.ln_g + ch0), lb = *(const f32x4*)(P.ln_b + ch0);
#pragma unroll
        for (int k = 0; k < 16; ++k) { const f32x4 p = *(const LAS f32x4*)(P2 + (th * 16 + k) * 4); const float rstd = rsqrtf(((p.x + p.y) + (p.z + p.w)) * (1.f / D) + EPS);
            f32x4 y = acc[k] * rstd * lg + lb;
#pragma unroll
            for (int i = 0; i < 4; ++i) y[i] = y[i] * pg8::fast_sigmoid(y[i]);
            *(GAS unsigned long long*)(UC + (size_t)(row0 + th * 16 + k) * D + ch0) = (unsigned long long)pk2(y.x, y.y) | ((unsigned long long)pk2(y.z, y.w) << 32); }
    }
    __syncthreads();
}
__device__ __forceinline__ void p6_combine(Frame& F, const Ptrs& P, const bf16* O1, const bf16* O2, const bf16* YC, const bf16* GA, bf16* Z) {
    const int gw = F.vcu * NWAVES + F.wave, NGW = F.G * NWAVES;
    const float lam = gload_f32(P.mod + 4 * 6144); const f32x4 hn4 = *(const f32x4*)(P.hn + 4 * (F.lane & 31)) * (1.f - LAM_INIT);
    for (int row = gw; row < M; row += NGW) { const size_t off = (size_t)row * D + 4 * F.lane;
#pragma unroll
        for (int j = 0; j < 4; ++j) { const v2u r1 = *(const GAS v2u*)(O1 + off + 256 * j), r2 = *(const GAS v2u*)(O2 + off + 256 * j), ry = *(const GAS v2u*)(YC + off + 256 * j), rg = *(const GAS v2u*)(GA + off + 256 * j);
            const f32x4 a = bf4(r1.x, r1.y) - bf4(r2.x, r2.y) * lam; float ss = (a.x * a.x + a.y * a.y) + (a.z * a.z + a.w * a.w);
#pragma unroll
            for (int o = 1; o < 32; o <<= 1) ss += __shfl_xor(ss, o);
            const float rstd = rsqrtf(ss * (1.f / VD) + EPS);
            const f32x4 z = bf4(ry.x, ry.y) + bf4(rg.x, rg.y) * (a * rstd * hn4);
            *(GAS unsigned long long*)(Z + off + 256 * j) = (unsigned long long)pk2(z.x, z.y) | ((unsigned long long)pk2(z.z, z.w) << 32); } }
}
__device__ __forceinline__ void p8_x1(Frame& F, const Ptrs& P, const bf16* Y, bf16* XN) {
    const int gw = F.vcu * NWAVES + F.wave, NGW = F.G * NWAVES;
    for (int b = 0; b < BATCH; ++b) {
        const float* mb = P.mod + b * 6144; f32x4 G1[4], A2[4], B2[4];
#pragma unroll
        for (int j = 0; j < 4; ++j) { const int c = 4 * F.lane + 256 * j; G1[j] = *(const f32x4*)(mb + 2048 + c) * *(const f32x4*)(P.post1 + c);
            A2[j] = *(const f32x4*)(P.pre2 + c) * (*(const f32x4*)(mb + 4096 + c) + 1.0f); B2[j] = *(const f32x4*)(mb + 3072 + c); }
        for (int r = gw; r < T; r += NGW) { const size_t row = (size_t)b * T + r, off = row * D + 4 * F.lane;
            f32x4 y[4], xv[4]; float s = 0.f;
#pragma unroll
            for (int j = 0; j < 4; ++j) { const v2u ry = *(const GAS v2u*)(Y + off + 256 * j); y[j] = bf4(ry.x, ry.y); xv[j] = *(const GAS f32x4*)(P.x + off + 256 * j);
                s += (y[j].x * y[j].x + y[j].y * y[j].y) + (y[j].z * y[j].z + y[j].w * y[j].w); }
            const float rstd = rsqrtf(wave_sum(s) * (1.f / D) + EPS); float s2 = 0.f;
#pragma unroll
            for (int j = 0; j < 4; ++j) { xv[j] = xv[j] + G1[j] * (y[j] * rstd); *(GAS f32x4*)(P.out + off + 256 * j) = xv[j];
                s2 += (xv[j].x * xv[j].x + xv[j].y * xv[j].y) + (xv[j].z * xv[j].z + xv[j].w * xv[j].w); }
            const float rstd2 = rsqrtf(wave_sum(s2) * (1.f / D) + EPS);
#pragma unroll
            for (int j = 0; j < 4; ++j) { const f32x4 o = xv[j] * rstd2 * A2[j] + B2[j];
                *(GAS unsigned long long*)(XN + off + 256 * j) = (unsigned long long)pk2(o.x, o.y) | ((unsigned long long)pk2(o.z, o.w) << 32); } }
    }
}
__device__ __forceinline__ void p11_out(Frame& F, const Ptrs& P, const bf16* Fb) {
    const int gw = F.vcu * NWAVES + F.wave, NGW = F.G * NWAVES;
    for (int b = 0; b < BATCH; ++b) {
        const float* mb = P.mod + b * 6144; f32x4 G2[4];
#pragma unroll
        for (int j = 0; j < 4; ++j) { const int c = 4 * F.lane + 256 * j; G2[j] = *(const f32x4*)(mb + 5120 + c) * *(const f32x4*)(P.post2 + c); }
        for (int r = gw; r < T; r += NGW) { const size_t row = (size_t)b * T + r, off = row * D + 4 * F.lane;
            f32x4 y[4], xv[4]; float s = 0.f;
#pragma unroll
            for (int j = 0; j < 4; ++j) { const v2u ry = *(const GAS v2u*)(Fb + off + 256 * j); y[j] = bf4(ry.x, ry.y); xv[j] = *(const GAS f32x4*)(P.out + off + 256 * j);
                s += (y[j].x * y[j].x + y[j].y * y[j].y) + (y[j].z * y[j].z + y[j].w * y[j].w); }
            const float rstd = rsqrtf(wave_sum(s) * (1.f / D) + EPS);
#pragma unroll
            for (int j = 0; j < 4; ++j) *(GAS f32x4*)(P.out + off + 256 * j) = xv[j] + G2[j] * (y[j] * rstd); }
    }
}

struct Args { const float* in[23]; float* out; unsigned char* ws; int ph_lo, ph_hi, li, pad; };
__global__ void __launch_bounds__(NWAVES * 64, 2) mega_fwd(Args args) {
    extern __shared__ __attribute__((aligned(16))) unsigned char lds[];
    Frame F;
    F.lds = (LAS unsigned char*)lds;
    F.MISC = (volatile LAS unsigned*)(F.lds + MISC_OFF);
    F.tid = threadIdx.x; F.lane = F.tid & 63; F.wave = __builtin_amdgcn_readfirstlane(F.tid >> 6);
    F.G = gridDim.x; { const int bx = blockIdx.x; F.vcu = (F.G % 8 == 0) ? (bx % 8) * (F.G / 8) + bx / 8 : bx; }
    unsigned char* ws = args.ws;
    Ptrs P;
    P.x = args.in[0]; P.c = args.in[1]; P.w_ada = args.in[2]; P.b_ada = args.in[3]; P.pre1 = args.in[4]; P.post1 = args.in[5]; P.w_in = args.in[6]; P.conv_w = args.in[7];
    P.conv_b = args.in[8]; P.ln_g = args.in[9]; P.ln_b = args.in[10]; P.wc_out = args.in[11]; P.bc_out = args.in[12]; P.lq1 = args.in[13]; P.lk1 = args.in[14]; P.lq2 = args.in[15];
    P.lk2 = args.in[16]; P.hn = args.in[17]; P.w_o = args.in[18]; P.pre2 = args.in[19]; P.post2 = args.in[20]; P.w1 = args.in[21]; P.w2 = args.in[22];
    P.out = args.out; P.mod = (float*)(ws + WS_MOD); P.rope = (float*)(ws + WS_ROPET);
    P.WIN = (bf16*)(ws + WS_WIN); P.WC = (bf16*)(ws + WS_WC); P.WO = (bf16*)(ws + WS_WO); P.W1 = (bf16*)(ws + WS_W1); P.W2 = (bf16*)(ws + WS_W2);
#pragma unroll
    for (int i = 0; i < 7; ++i) P.R[i] = (bf16*)(ws + WS_R0 + (size_t)i * RSZ);
    for (int u = F.tid; u < (LDS_BYTES - LDSCTL_OFF) / 4; u += NWAVES * 64) ((LAS unsigned*)(F.lds + LDSCTL_OFF))[u] = 0u;
    __syncthreads();
    XcdBarrier bar = xcd_barrier_post((unsigned*)(ws + WS_CTL) + CW_BAR + args.li * XCD_BAR_WORDS, F.MISC + 8);
    const int lo = args.ph_lo, hi = args.ph_hi;
#ifndef PHMASK
#define PHMASK 0xFFF
#endif
#define IN(k) ((((PHMASK) >> (k)) & 1) && lo <= (k) && (k) < hi)
#define SEAM(k) do { if (IN(k) && IN((k) + 1)) xcd_barrier(bar); } while (0)
    bf16 *XN = P.R[0], *U = P.R[1], *Q = P.R[2], *Kb = P.R[3], *V = P.R[4], *GC = P.R[5], *GA = P.R[6];
    bf16 *UC = P.R[0], *YC = P.R[1], *O1 = P.R[0], *O2 = P.R[5], *Z = P.R[2], *Y = P.R[3], *F1 = P.R[1], *Fb = P.R[5];

    if (IN(0)) { p0_prologue(F, P); SEAM(0); }
    if (IN(1)) { p1_h1(F, P, XN); SEAM(1); }
    if (IN(2)) {
        pg8::Gemm g{XN, P.WIN, M, DIN, D}; pg8::StaticOrder S; S.init(M, DIN, F.G, (int)blockIdx.x);
        pg8::EpiProj E{U, Q, Kb, V, GC, GA, P.rope};
        pg8::gemm_phase<pg8::EpiProj, pg8::StaticOrder, PG8_ALIGN, PG8_SP2>(F.lds + RING_OFF, g, S, E);
        SEAM(2); }
    if (IN(3)) { p3_conv(F, P, U, UC); SEAM(3); }
    if (IN(4)) {
        pg8::Gemm g{UC, P.WC, M, D, D}; pg8::StaticOrder S; S.init(M, D, F.G, (int)blockIdx.x);
        pg8::EpiPlain<1> E{YC, D, P.bc_out, GC};
        pg8::gemm_phase<pg8::EpiPlain<1>, pg8::StaticOrder, PG8_ALIGN, PG8_SP2>(F.lds + RING_OFF, g, S, E);
        SEAM(4); }
    if (IN(5)) {
        const attn_body::AttnTensors AT{(const attn_body::bf16*)Q, (const attn_body::bf16*)Kb, (const attn_body::bf16*)V, (attn_body::bf16*)O1, (attn_body::bf16*)O2};
        const attn_body::DealOrder S(F.vcu);
        if (F.G == 256) attn_body::attn_phase<attn_body::DealOrder>((char*)lds + RING_OFF, AT, S);
        SEAM(5); }
    if (IN(6)) { p6_combine(F, P, O1, O2, YC, GA, Z); SEAM(6); }
    if (IN(7)) {
        pg8::Gemm g{Z, P.WO, M, D, D}; pg8::StaticOrder S; S.init(M, D, F.G, (int)blockIdx.x);
        pg8::EpiPlain<0> E{Y, D, nullptr, nullptr};
        pg8::gemm_phase<pg8::EpiPlain<0>, pg8::StaticOrder, PG8_ALIGN, PG8_SP2>(F.lds + RING_OFF, g, S, E);
        SEAM(7); }
    if (IN(8)) { p8_x1(F, P, Y, XN); SEAM(8); }
    if (IN(9)) {
        pg8::Gemm g{XN, P.W1, M, FF, D}; pg8::StaticOrder S; S.init(M, FF, F.G, (int)blockIdx.x);
        pg8::EpiPlain<2> E{F1, FF, nullptr, nullptr};
        pg8::gemm_phase<pg8::EpiPlain<2>, pg8::StaticOrder, PG8_ALIGN, PG8_SP2>(F.lds + RING_OFF, g, S, E);
        SEAM(9); }
    if (IN(10)) {
        pg8::Gemm g{F1, P.W2, M, D, FF}; pg8::StaticOrder S; S.init(M, D, F.G, (int)blockIdx.x);
        pg8::EpiPlain<0> E{Fb, D, nullptr, nullptr};
        pg8::gemm_phase<pg8::EpiPlain<0>, pg8::StaticOrder, PG8_ALIGN, PG8_SP2>(F.lds + RING_OFF, g, S, E);
        SEAM(10); }
    if (IN(11)) { p11_out(F, P, Fb); }
#undef IN
#undef SEAM
}

#ifndef FASTMASK
#define PATCH_YN 16
#define FASTMASK 0xFFF
#endif
extern "C" void kernel_launch(void* const* d_in, const int* in_sizes, int n_in, void* d_out, int out_size, void* d_ws, size_t ws_size, hipStream_t stream) {
    static int grid = 0;
    if (grid == 0) {
        if (n_in != 23 || in_sizes[0] != M * D || out_size != M * D || ws_size < WS_END) { fprintf(stderr, "kernel_launch: unexpected shapes (n_in %d in0 %d out %d ws %zu)\n", n_in, n_in > 0 ? in_sizes[0] : -1, out_size, ws_size); grid = -1; return; }
        int dev = 0, cus = 0;
        if (hipGetDevice(&dev) != hipSuccess || hipDeviceGetAttribute(&cus, hipDeviceAttributeMultiprocessorCount, dev) != hipSuccess) { fprintf(stderr, "kernel_launch: device query failed\n"); grid = -1; return; }
        if (hipFuncSetAttribute((const void*)mega_fwd, hipFuncAttributeMaxDynamicSharedMemorySize, LDS_BYTES) != hipSuccess) { fprintf(stderr, "kernel_launch: hipFuncSetAttribute failed\n"); grid = -1; return; }
        (void)hipGetLastError();
        grid = cus;
        if (grid != 256) fprintf(stderr, "kernel_launch: %d CUs; the attention phase is dealt for 256\n", grid);
    }
    if (grid < 0) return;
    const float* x = (const float*)d_in[0]; const float* c = (const float*)d_in[1]; const float* w_ada = (const float*)d_in[2]; const float* b_ada = (const float*)d_in[3];
    const float* pre1 = (const float*)d_in[4]; const float* post1 = (const float*)d_in[5]; const float* w_in = (const float*)d_in[6]; const float* conv_w = (const float*)d_in[7];
    const float* conv_b = (const float*)d_in[8]; const float* ln_g = (const float*)d_in[9]; const float* ln_b = (const float*)d_in[10]; const float* wc_out = (const float*)d_in[11];
    const float* bc_out = (const float*)d_in[12]; const float* lq1 = (const float*)d_in[13]; const float* lk1 = (const float*)d_in[14]; const float* lq2 = (const float*)d_in[15];
    const float* lk2 = (const float*)d_in[16]; const float* hn = (const float*)d_in[17]; const float* w_o = (const float*)d_in[18]; const float* pre2 = (const float*)d_in[19];
    const float* post2 = (const float*)d_in[20]; const float* w1 = (const float*)d_in[21]; const float* w2 = (const float*)d_in[22];
    float* out = (float*)d_out; unsigned char* ws = (unsigned char*)d_ws;
    float* mod = (float*)(ws + WS_MOD);
    bf16* R[7]; for (int i = 0; i < 7; ++i) R[i] = (bf16*)(ws + WS_R0 + i * RSZ);
    bf16 *XN = R[0], *U = R[1], *Q = R[2], *Kb = R[3], *V = R[4], *GC = R[5], *GA = R[6];
    bf16 *UC = R[0], *YC = R[1], *O1 = R[0], *O2 = R[5], *Z = R[2], *Y = R[3], *F1 = R[1], *F = R[5];
    (void)hipMemsetAsync(ws + WS_CTL, 0, CTL_ZERO_BYTES, stream);
    Args a{};
    for (int i = 0; i < 23; ++i) a.in[i] = (const float*)d_in[i];
    a.out = out; a.ws = ws;
    int li = 0;
    auto mega = [&](int lo, int hi) { a.ph_lo = lo; a.ph_hi = hi; a.li = li++; hipLaunchKernelGGL(mega_fwd, dim3(grid), dim3(NWAVES * 64), LDS_BYTES, stream, a);
        const hipError_t le = hipPeekAtLastError(); if (le != hipSuccess) fprintf(stderr, "kernel_launch: launch [%d,%d) failed: %s\n", lo, hi, hipGetErrorName(le)); };
    const unsigned mask = FASTMASK;
#ifndef SPLIT_LAUNCHES
#define SPLIT_LAUNCHES 0
#endif
    if (mask == 0xFFFu && !SPLIT_LAUNCHES) { mega(0, 12); return; }
    if (mask == 0xFFFu) { for (int s = 0; s < 12; ++s) mega(s, s + 1); return; }
    auto naive = [&](int s) {
        switch (s) {
        case 0: nv_mod<<<dim3(6144 / 256, BATCH), 256, 0, stream>>>(c, w_ada, b_ada, lq1, lk1, lq2, lk2, mod); break;
        case 1: nv_h1<<<M, 256, 0, stream>>>(x, mod, pre1, XN); break;
        case 2: nv_gemm<NvProj><<<dim3(M / 64, 3584 / 64), 256, 0, stream>>>(XN, D, w_in, DIN, NvProj{U, Q, Kb, V, GC, GA}); break;
        case 3: nv_conv<<<M, 256, 0, stream>>>(U, conv_w, conv_b, ln_g, ln_b, UC); break;
        case 4: nv_gemm<NvPlain<1>><<<dim3(M / 64, 512 / 64), 256, 0, stream>>>(UC, D, wc_out, D, NvPlain<1>{YC, D, 512, bc_out, GC}); break;
        case 5: nv_attn<<<dim3(T / 128, 32, BATCH), 128, 0, stream>>>(Q, Kb, V, O1, O2); break;
        case 6: nv_combine<<<M, 256, 0, stream>>>(O1, O2, YC, GA, hn, mod, Z); break;
        case 7: nv_gemm<NvPlain<0>><<<dim3(M / 64, 512 / 64), 256, 0, stream>>>(Z, D, w_o, D, NvPlain<0>{Y, D, 512, nullptr, nullptr}); break;
        case 8: nv_x1<<<M, 256, 0, stream>>>(x, Y, mod, post1, pre2, out, XN); break;
        case 9: nv_gemm<NvPlain<2>><<<dim3(M / 64, 2048 / 64), 256, 0, stream>>>(XN, D, w1, FF, NvPlain<2>{F1, FF, 2048, nullptr, nullptr}); break;
        case 10: nv_gemm<NvPlain<0>><<<dim3(M / 64, 512 / 64), 256, 0, stream>>>(F1, FF, w2, D, NvPlain<0>{F, D, 512, nullptr, nullptr}); break;
        default: nv_out<<<M, 256, 0, stream>>>(F, mod, post2, out); break;
        } };
    const bool need_w = (mask & ((1u << 2) | (1u << 4) | (1u << 7) | (1u << 9) | (1u << 10))) != 0;
    int s = 0;
    if (!(mask & 1u)) { if (need_w) mega(0, 1); naive(0); s = 1; }
    while (s < 12) {
        if ((mask >> s) & 1u) { int e = s; while (e < 12 && ((mask >> e) & 1u)) ++e; mega(s, e);
#ifdef PATCH_Y0
            if (s <= 2 && e > 2) nv_gemm<NvProj><<<dim3(M / 64, PATCH_YN), 256, 0, stream>>>(XN, D, w_in, DIN, NvProj{U, Q, Kb, V, GC, GA}, PATCH_Y0);
#endif
            s = e; }
        else { naive(s); ++s; }
    }
}
```

```cpp
#include <hip/hip_runtime.h>
#include <cstdio>
#include <cstdint>
#include <cmath>

constexpr int BATCH = 4, T = 8192, D = 1024, M = BATCH * T, DIN = 7168, FF = 4096, NH = 8, HD = 64, VD = 128, CWID = 31;
constexpr float EPS = 1e-6f, LAM_INIT = 0.2f;
constexpr float C2 = 0.18033688011112042f;

typedef unsigned short bf16;
__device__ __forceinline__ float bf2f(bf16 v) { return __uint_as_float(((unsigned)v) << 16); }
__device__ __forceinline__ unsigned f2bf(float f) { unsigned u = __float_as_uint(f); return (u + 0x7fffu + ((u >> 16) & 1u)) >> 16; }
__device__ __forceinline__ unsigned pk2(float lo, float hi) { return f2bf(lo) | (f2bf(hi) << 16); }
__device__ __forceinline__ float sigmoidf_(float v) { return 1.f / (1.f + __expf(-v)); }

constexpr size_t MiB = 1u << 20;
constexpr size_t WS_CTL = 0;
constexpr size_t WS_MOD = 1 * MiB;
constexpr size_t WS_ROPE = 1 * MiB + 512 * 1024;
constexpr size_t WS_R0 = 40 * MiB;
constexpr size_t RSZ = 64 * MiB;
constexpr size_t WS_END = WS_R0 + 7 * RSZ;

__device__ __forceinline__ float block_sum256(float v, float* red) {
#pragma unroll
    for (int o = 1; o < 64; o <<= 1) v += __shfl_xor(v, o);
    __syncthreads();
    if ((threadIdx.x & 63) == 0) red[threadIdx.x >> 6] = v;
    __syncthreads();
    return (red[0] + red[1]) + (red[2] + red[3]);
}

__global__ void __launch_bounds__(256) nv_mod(const float* c, const float* w_ada, const float* b_ada, const float* lq1, const float* lk1, const float* lq2, const float* lk2, float* mod) {
    const int col = blockIdx.x * 256 + threadIdx.x, b = blockIdx.y;
    float acc = 0.f;
    for (int k = 0; k < D; ++k) { const float cv = c[b * D + k]; acc += (cv * sigmoidf_(cv)) * w_ada[(size_t)k * 6144 + col]; }
    mod[b * 6144 + col] = acc + b_ada[col];
    if (blockIdx.x == 0 && blockIdx.y == 0 && threadIdx.x == 0) {
        float s1 = 0.f, s2 = 0.f;
        for (int i = 0; i < 64; ++i) { s1 += lq1[i] * lk1[i]; s2 += lq2[i] * lk2[i]; }
        mod[4 * 6144] = __expf(s1) - __expf(s2) + LAM_INIT;
    }
}

__global__ void __launch_bounds__(256) nv_h1(const float* x, const float* mod, const float* g, bf16* XN) {
    __shared__ float red[4];
    const int row = blockIdx.x, b = row / T, tid = threadIdx.x, c0 = tid * 4;
    const float4 v = ((const float4*)(x + (size_t)row * D))[tid];
    const float ss = block_sum256(v.x * v.x + v.y * v.y + v.z * v.z + v.w * v.w, red);
    const float rstd = rsqrtf(ss * (1.f / D) + EPS);
    const float* sh = mod + b * 6144; const float* sc = sh + 1024;
    const float vv[4] = {v.x, v.y, v.z, v.w}; float o[4];
#pragma unroll
    for (int j = 0; j < 4; ++j) o[j] = vv[j] * rstd * g[c0 + j] * (1.f + sc[c0 + j]) + sh[c0 + j];
    uint2 w; w.x = pk2(o[0], o[1]); w.y = pk2(o[2], o[3]);
    *(uint2*)(XN + (size_t)row * D + c0) = w;
}

template <class E> __global__ void __launch_bounds__(256) nv_gemm(const bf16* A, int K, const float* W, int ldw, E e, int yoff = 0) {
    __shared__ float As[64][36];
    const int tid = threadIdx.x, ix = tid & 63, iy = tid >> 6;
    const int row0 = blockIdx.x * 64, item = (blockIdx.y + yoff) * 64 + ix;
    int c0, c1; e.cols(item, c0, c1);
    float acc0[16], acc1[16];
#pragma unroll
    for (int r = 0; r < 16; ++r) { acc0[r] = 0.f; acc1[r] = 0.f; }
    for (int k0 = 0; k0 < K; k0 += 32) {
        { const int r = tid >> 2, kc = (tid & 3) * 8;
          const uint4 raw = *(const uint4*)(A + (size_t)(row0 + r) * K + k0 + kc);
          const unsigned w[4] = {raw.x, raw.y, raw.z, raw.w};
#pragma unroll
          for (int j = 0; j < 4; ++j) { As[r][kc + 2 * j] = __uint_as_float(w[j] << 16); As[r][kc + 2 * j + 1] = __uint_as_float(w[j] & 0xffff0000u); } }
        __syncthreads();
#pragma unroll 2
        for (int kk = 0; kk < 32; kk += 4) {
            float w0[4], w1[4];
#pragma unroll
            for (int j = 0; j < 4; ++j) { w0[j] = W[(size_t)(k0 + kk + j) * ldw + c0]; w1[j] = W[(size_t)(k0 + kk + j) * ldw + c1]; }
#pragma unroll
            for (int r = 0; r < 16; ++r) { const float4 a = *(const float4*)&As[iy * 16 + r][kk];
                acc0[r] += a.x * w0[0] + a.y * w0[1] + a.z * w0[2] + a.w * w0[3];
                acc1[r] += a.x * w1[0] + a.y * w1[1] + a.z * w1[2] + a.w * w1[3]; }
        }
        __syncthreads();
    }
#pragma unroll
    for (int r = 0; r < 16; ++r) e.store(row0 + iy * 16 + r, item, acc0[r], acc1[r]);
}

struct NvProj {
    bf16 *U, *Q, *Kb, *V, *GC, *GA;
    __device__ void cols(int item, int& c0, int& c1) const {
        if (item < 1024) { c0 = item; c1 = 1024 + item; }
        else if (item < 2048) { const int i = item - 1024, qk = i >> 9, j = i & 511, mh = j >> 5, d = j & 31; c0 = 2048 + qk * 1024 + mh * 64 + d; c1 = c0 + 32; }
        else if (item < 2560) { const int i = item - 2048; c0 = 4096 + i; c1 = 4096 + 512 + i; }
        else { const int i = item - 2560; c0 = 5120 + i; c1 = 6144 + i; }
    }
    __device__ void store(int row, int item, float a0, float a1) const {
        if (item < 1024) { U[(size_t)row * D + item] = (bf16)f2bf(a0 * sigmoidf_(a1)); }
        else if (item < 2048) { const int i = item - 1024, qk = i >> 9, j = i & 511, mh = j >> 5, d = j & 31; const int t = row % T;
            const float invf = powf(10000.f, -(float)d / 32.f), ang = (float)t * invf; const float cs = cosf(ang), sn = sinf(ang);
            float o1 = a0 * cs - a1 * sn, o2 = a1 * cs + a0 * sn; bf16* P = qk ? Kb : Q; if (!qk) { o1 *= C2; o2 *= C2; }
            P[(size_t)row * D + mh * 64 + d] = (bf16)f2bf(o1); P[(size_t)row * D + mh * 64 + 32 + d] = (bf16)f2bf(o2); }
        else if (item < 2560) { const int i = item - 2048; V[(size_t)row * D + i] = (bf16)f2bf(a0); V[(size_t)row * D + 512 + i] = (bf16)f2bf(a1); }
        else { const int i = item - 2560; GC[(size_t)row * D + i] = (bf16)f2bf(sigmoidf_(a0)); GA[(size_t)row * D + i] = (bf16)f2bf(sigmoidf_(a1)); }
    }
};
template <int MODE> struct NvPlain {
    bf16* O; int ldo, nhalf; const float* bias; const bf16* G;
    __device__ void cols(int item, int& c0, int& c1) const { c0 = item; c1 = nhalf + item; }
    __device__ float f(int row, int c, float a) const {
        if (MODE == 1) return bf2f(G[(size_t)row * ldo + c]) * (a + bias[c]);
        if (MODE == 2) { const float r = a > 0.f ? a : 0.f; return r * r; }
        return a; }
    __device__ void store(int row, int item, float a0, float a1) const {
        O[(size_t)row * ldo + item] = (bf16)f2bf(f(row, item, a0)); O[(size_t)row * ldo + nhalf + item] = (bf16)f2bf(f(row, nhalf + item, a1)); }
};

__global__ void __launch_bounds__(256) nv_conv(const bf16* U, const float* cw, const float* cb, const float* lg, const float* lb, bf16* UC) {
    __shared__ float red[4];
    const int row = blockIdx.x, t = row % T, tid = threadIdx.x, c0 = tid * 4;
    float a[4];
#pragma unroll
    for (int j = 0; j < 4; ++j) a[j] = cb[c0 + j];
    for (int i = 0; i < CWID; ++i) { const int tt = t - (CWID - 1) + i; if (tt < 0) continue;
        const uint2 raw = *(const uint2*)(U + (size_t)(row - (CWID - 1) + i) * D + c0);
        const float4 w = *(const float4*)(cw + (size_t)i * D + c0);
        a[0] += __uint_as_float(raw.x << 16) * w.x; a[1] += __uint_as_float(raw.x & 0xffff0000u) * w.y;
        a[2] += __uint_as_float(raw.y << 16) * w.z; a[3] += __uint_as_float(raw.y & 0xffff0000u) * w.w; }
    const float mean = block_sum256((a[0] + a[1]) + (a[2] + a[3]), red) * (1.f / D);
    float q = 0.f;
#pragma unroll
    for (int j = 0; j < 4; ++j) { a[j] -= mean; q += a[j] * a[j]; }
    const float rstd = rsqrtf(block_sum256(q, red) * (1.f / D) + EPS);
    float o[4];
#pragma unroll
    for (int j = 0; j < 4; ++j) { const float y = a[j] * rstd * lg[c0 + j] + lb[c0 + j]; o[j] = y * sigmoidf_(y); }
    uint2 w; w.x = pk2(o[0], o[1]); w.y = pk2(o[2], o[3]);
    *(uint2*)(UC + (size_t)row * D + c0) = w;
}

__global__ void __launch_bounds__(128) nv_attn(const bf16* Q, const bf16* Kb, const bf16* V, bf16* O1, bf16* O2) {
    __shared__ float Ks[64][64]; __shared__ float Vs[64][64];
    const int tid = threadIdx.x, qb = blockIdx.x, vhd = blockIdx.y, b = blockIdx.z;
    const int s = vhd >> 4, h = (vhd >> 1) & 7, vh = vhd & 1, mh = s * 8 + h;
    const int qi = qb * 128 + tid; const size_t rowbase = (size_t)b * T;
    float q[64], o[64];
    { const bf16* qp = Q + (rowbase + qi) * D + mh * 64;
#pragma unroll
      for (int d = 0; d < 64; d += 2) { const unsigned w = *(const unsigned*)(qp + d); q[d] = __uint_as_float(w << 16); q[d + 1] = __uint_as_float(w & 0xffff0000u); } }
#pragma unroll
    for (int e = 0; e < 64; ++e) o[e] = 0.f;
    float m = -1e30f, l = 0.f;
    const int nt = (qb * 128 + 128) / 64;
    for (int kt = 0; kt < nt; ++kt) {
        __syncthreads();
        for (int i = tid; i < 64 * 32; i += 128) { const int r = i >> 5, c = (i & 31) * 2;
            const unsigned kw = *(const unsigned*)(Kb + (rowbase + kt * 64 + r) * D + mh * 64 + c);
            const unsigned vw = *(const unsigned*)(V + (rowbase + kt * 64 + r) * D + h * 128 + vh * 64 + c);
            Ks[r][c] = __uint_as_float(kw << 16); Ks[r][c + 1] = __uint_as_float(kw & 0xffff0000u);
            Vs[r][c] = __uint_as_float(vw << 16); Vs[r][c + 1] = __uint_as_float(vw & 0xffff0000u); }
        __syncthreads();
        for (int j = 0; j < 64; ++j) {
            if (kt * 64 + j > qi) break;
            float sdot = 0.f;
#pragma unroll
            for (int d = 0; d < 64; d += 4) { const float4 kv = *(const float4*)&Ks[j][d]; sdot += q[d] * kv.x + q[d + 1] * kv.y + q[d + 2] * kv.z + q[d + 3] * kv.w; }
            if (sdot > m) { const float f = exp2f(m - sdot); l *= f;
#pragma unroll
                for (int e = 0; e < 64; ++e) o[e] *= f;
                m = sdot; }
            const float p = exp2f(sdot - m); l += p;
#pragma unroll
            for (int e = 0; e < 64; e += 4) { const float4 vv = *(const float4*)&Vs[j][e]; o[e] += p * vv.x; o[e + 1] += p * vv.y; o[e + 2] += p * vv.z; o[e + 3] += p * vv.w; }
        }
    }
    const float rl = 1.f / l; bf16* op = (s ? O2 : O1) + (rowbase + qi) * D + h * 128 + vh * 64;
#pragma unroll
    for (int e = 0; e < 64; e += 2) *(unsigned*)(op + e) = pk2(o[e] * rl, o[e + 1] * rl);
}

__global__ void __launch_bounds__(256) nv_combine(const bf16* O1, const bf16* O2, const bf16* YC, const bf16* GA, const float* hn, const float* mod, bf16* Z) {
    const int row = blockIdx.x, tid = threadIdx.x, c0 = tid * 4; const float lam = mod[4 * 6144];
    const size_t off = (size_t)row * D + c0;
    const uint2 r1 = *(const uint2*)(O1 + off), r2 = *(const uint2*)(O2 + off), ry = *(const uint2*)(YC + off), rg = *(const uint2*)(GA + off);
    float a[4] = {__uint_as_float(r1.x << 16) - lam * __uint_as_float(r2.x << 16), __uint_as_float(r1.x & 0xffff0000u) - lam * __uint_as_float(r2.x & 0xffff0000u),
                  __uint_as_float(r1.y << 16) - lam * __uint_as_float(r2.y << 16), __uint_as_float(r1.y & 0xffff0000u) - lam * __uint_as_float(r2.y & 0xffff0000u)};
    float ss = (a[0] * a[0] + a[1] * a[1]) + (a[2] * a[2] + a[3] * a[3]);
#pragma unroll
    for (int o = 1; o < 32; o <<= 1) ss += __shfl_xor(ss, o);
    const float rstd = rsqrtf(ss * (1.f / VD) + EPS) * (1.f - LAM_INIT);
    const float yc[4] = {__uint_as_float(ry.x << 16), __uint_as_float(ry.x & 0xffff0000u), __uint_as_float(ry.y << 16), __uint_as_float(ry.y & 0xffff0000u)};
    const float ga[4] = {__uint_as_float(rg.x << 16), __uint_as_float(rg.x & 0xffff0000u), __uint_as_float(rg.y << 16), __uint_as_float(rg.y & 0xffff0000u)};
    float z[4];
#pragma unroll
    for (int j = 0; j < 4; ++j) z[j] = yc[j] + ga[j] * (a[j] * rstd * hn[(c0 + j) & 127]);
    uint2 w; w.x = pk2(z[0], z[1]); w.y = pk2(z[2], z[3]);
    *(uint2*)(Z + off) = w;
}

__global__ void __launch_bounds__(256) nv_x1(const float* x, const bf16* Y, const float* mod, const float* post1, const float* pre2, float* out, bf16* XN) {
    __shared__ float red[4];
    const int row = blockIdx.x, b = row / T, tid = threadIdx.x, c0 = tid * 4;
    const uint2 ry = *(const uint2*)(Y + (size_t)row * D + c0);
    const float y[4] = {__uint_as_float(ry.x << 16), __uint_as_float(ry.x & 0xffff0000u), __uint_as_float(ry.y << 16), __uint_as_float(ry.y & 0xffff0000u)};
    const float rstd = rsqrtf(block_sum256((y[0] * y[0] + y[1] * y[1]) + (y[2] * y[2] + y[3] * y[3]), red) * (1.f / D) + EPS);
    const float* mb = mod + b * 6144; const float4 xv = ((const float4*)(x + (size_t)row * D))[tid];
    const float xx[4] = {xv.x, xv.y, xv.z, xv.w}; float x1[4]; float ss = 0.f;
#pragma unroll
    for (int j = 0; j < 4; ++j) { x1[j] = xx[j] + mb[2048 + c0 + j] * (y[j] * rstd * post1[c0 + j]); ss += x1[j] * x1[j]; }
    ((float4*)(out + (size_t)row * D))[tid] = make_float4(x1[0], x1[1], x1[2], x1[3]);
    const float rstd2 = rsqrtf(block_sum256(ss, red) * (1.f / D) + EPS);
    float o[4];
#pragma unroll
    for (int j = 0; j < 4; ++j) o[j] = x1[j] * rstd2 * pre2[c0 + j] * (1.f + mb[4096 + c0 + j]) + mb[3072 + c0 + j];
    uint2 w; w.x = pk2(o[0], o[1]); w.y = pk2(o[2], o[3]);
    *(uint2*)(XN + (size_t)row * D + c0) = w;
}
__global__ void __launch_bounds__(256) nv_out(const bf16* F, const float* mod, const float* post2, float* out) {
    __shared__ float red[4];
    const int row = blockIdx.x, b = row / T, tid = threadIdx.x, c0 = tid * 4;
    const uint2 rf = *(const uint2*)(F + (size_t)row * D + c0);
    const float f[4] = {__uint_as_float(rf.x << 16), __uint_as_float(rf.x & 0xffff0000u), __uint_as_float(rf.y << 16), __uint_as_float(rf.y & 0xffff0000u)};
    const float rstd = rsqrtf(block_sum256((f[0] * f[0] + f[1] * f[1]) + (f[2] * f[2] + f[3] * f[3]), red) * (1.f / D) + EPS);
    const float* mb = mod + b * 6144; float4 xv = ((const float4*)(out + (size_t)row * D))[tid];
    xv.x += mb[5120 + c0 + 0] * (f[0] * rstd * post2[c0 + 0]); xv.y += mb[5120 + c0 + 1] * (f[1] * rstd * post2[c0 + 1]);
    xv.z += mb[5120 + c0 + 2] * (f[2] * rstd * post2[c0 + 2]); xv.w += mb[5120 + c0 + 3] * (f[3] * rstd * post2[c0 + 3]);
    ((float4*)(out + (size_t)row * D))[tid] = xv;
}


namespace pg8 {
#define PG8_LAS __attribute__((address_space(3)))
typedef unsigned short bf16_t;
typedef short bf16x8 __attribute__((ext_vector_type(8)));
typedef float f32x4 __attribute__((ext_vector_type(4)));
typedef unsigned u32x4 __attribute__((ext_vector_type(4)));
constexpr int BM = 256, BK = 64, HALF = 128, HTB = HALF * BK * 2  , STAGE_BYTES = 8 * HTB, NXCD = 8, WGM = 8;

__host__ __device__ __forceinline__ int lds_byte(int r, int c) { const int st = (r >> 4) * 2 + (c >> 5), rr = r & 15, cc = c & 31, ob = rr * 64 + cc * 2; return st * 1024 + (ob ^ (((ob >> 9) & 1) << 5)); }
__host__ __device__ __forceinline__ void stage_rc(int b, int& R, int& C) { const int st = b / 1024, sb = b % 1024, swz = sb ^ (((sb >> 9) & 1) << 5); R = (st >> 1) * 16 + swz / 64; C = (st & 1) * 32 + (swz % 64) / 2; }
__host__ __device__ __forceinline__ int perm32(int rho) { const int n = rho >> 4, i = rho & 15; return 8 * (i >> 2) + 4 * n + (i & 3); }

struct Unit { int pm, pn; };
struct Gemm { const bf16_t* A; const bf16_t* Bt; int M, N, K; };

struct StaticOrder {
    int nM, nN, nwg, G, c;
    __host__ __device__ void init(int M, int N, int G_, int c_) { nM = M / BM; nN = N / BM; nwg = nM * nN; G = G_; c = c_; }
    __host__ __device__ bool next(int i, Unit& u) const {
        const long L = (long)i * G + c; if (L >= nwg) return false;
        int wgid = (int)L; { const int q = nwg / NXCD, r = nwg % NXCD, xcd = wgid % NXCD, off = wgid / NXCD; wgid = (xcd < r ? xcd * (q + 1) : r * (q + 1) + (xcd - r) * q) + off; }
        const int nig = WGM * nN, gid = wgid / nig, fm = gid * WGM, gsz = (nM - fm) < WGM ? (nM - fm) : WGM;
        u.pm = fm + ((wgid % nig) % gsz); u.pn = (wgid % nig) / gsz; return true;
    }
    __device__ __forceinline__ void a_ready(const Unit&) const {}
    __device__ __forceinline__ void done(const Unit&) const {}
};

typedef float f32x2_cv __attribute__((ext_vector_type(2))); typedef __bf16 bf16x2_cv __attribute__((ext_vector_type(2)));
__device__ __forceinline__ unsigned cvt_pk_bf16(float lo, float hi) { f32x2_cv v = {lo, hi}; bf16x2_cv b = __builtin_convertvector(v, bf16x2_cv); return __builtin_bit_cast(unsigned, b); }
typedef float f32x2 __attribute__((ext_vector_type(2)));
template <class Epi, class Sched, bool ALIGN_EPI = false, bool SP2 = false>
__device__ __forceinline__ void gemm_phase(PG8_LAS unsigned char* lds, const Gemm g, const Sched& S, const Epi& E) {
    const int tid = threadIdx.x, wid = __builtin_amdgcn_readfirstlane(tid >> 6), lane = tid & 63, wr = wid >> 2, wc = wid & 3, fr = lane & 15, fq = lane >> 4;
    const int K = g.K, nt = K / BK;
    unsigned voffA[2], voffB[2];
#pragma unroll
    for (int i = 0; i < 2; ++i) { int R, C; stage_rc(tid * 16 + i * 8192, R, C); const int Rb = Epi::PERM ? ((R & ~31) + perm32(R & 31)) : R;
        voffA[i] = (unsigned)(R * K + C) * 2u; voffB[i] = (unsigned)(Rb * K + C) * 2u; }
    const size_t kstep = (size_t)(BK * 2);
    const size_t hstep = (size_t)HALF * K * 2;
    const size_t tstep = 2 * hstep;
    const unsigned ldsw = (unsigned)wid * 1024u;
    const int aoff = lds_byte(wr * 64 + fr, fq * 8), boff = lds_byte(wc * 32 + fr, fq * 8);
#define PG8_SA(b, h) (((b) * 2 + (h)) * HTB)
#define PG8_SB(b, h) ((4 + (b) * 2 + (h)) * HTB)
#define PG8_STAGE(bufoff, gbase, voff) do { _Pragma("unroll") for (int _i = 0; _i < 2; ++_i) \
        __builtin_amdgcn_global_load_lds((const unsigned*)((const char*)(gbase) + (voff)[_i]), (PG8_LAS unsigned*)(lds + (bufoff) + ldsw + _i * 8192), 16, 0, 0); } while (0)
#define PG8_LDA(dst, b, h) do { _Pragma("unroll") for (int m = 0; m < 4; ++m) _Pragma("unroll") for (int k = 0; k < 2; ++k) dst[m][k] = *(const PG8_LAS bf16x8*)(lds + PG8_SA(b, h) + aoff + m * 2048 + k * 1024); } while (0)
#define PG8_LDB(dst, b, h) do { _Pragma("unroll") for (int n = 0; n < 2; ++n) _Pragma("unroll") for (int k = 0; k < 2; ++k) dst[n][k] = *(const PG8_LAS bf16x8*)(lds + PG8_SB(b, h) + boff + n * 2048 + k * 1024); } while (0)
#define PG8_MMA(ai, bj, At, Bt) do { __builtin_amdgcn_s_setprio(1); _Pragma("unroll") for (int m = 0; m < 4; ++m) _Pragma("unroll") for (int n = 0; n < 2; ++n) _Pragma("unroll") for (int k = 0; k < 2; ++k) \
        acc[ai][bj][m][n] = __builtin_amdgcn_mfma_f32_16x16x32_bf16(Bt[n][k], At[m][k], acc[ai][bj][m][n], 0, 0, 0); __builtin_amdgcn_s_setprio(0); } while (0)
#define PG8_WAIT_V(n) asm volatile("s_waitcnt vmcnt(" #n ")" ::: "memory")
#define PG8_WAIT_L(n) asm volatile("s_waitcnt lgkmcnt(" #n ")" ::: "memory")
#define PG8_BAR __builtin_amdgcn_s_barrier()
#define PG8_SCHED __builtin_amdgcn_sched_barrier(0)
    Unit cur, nxt; int ui = 0;
    if (!S.next(0, cur)) return;
    f32x4 acc[2][2][4][2];
#pragma unroll
    for (int a = 0; a < 2; ++a)
#pragma unroll
        for (int b = 0; b < 2; ++b)
#pragma unroll
            for (int m = 0; m < 4; ++m)
#pragma unroll
                for (int n = 0; n < 2; ++n) acc[a][b][m][n] = (f32x4){0.f, 0.f, 0.f, 0.f};
    bf16x8 At[4][2], B0[2][2], B1[2][2];
    const char* cA = (const char*)g.A + (size_t)cur.pm * tstep; const char* cB = (const char*)g.Bt + (size_t)cur.pn * tstep;
    S.a_ready(cur);
    if constexpr (SP2) {
        PG8_STAGE(PG8_SB(0, 0), cB, voffB); PG8_STAGE(PG8_SB(0, 1), cB + hstep, voffB); PG8_STAGE(PG8_SA(0, 0), cA, voffA); PG8_STAGE(PG8_SA(0, 1), cA + hstep, voffA);
        if (wr == 1) PG8_BAR;
        PG8_WAIT_V(2); PG8_BAR;
        PG8_STAGE(PG8_SB(1, 0), cB + kstep, voffB); PG8_STAGE(PG8_SA(1, 0), cA + kstep, voffA); PG8_STAGE(PG8_SB(1, 1), cB + hstep + kstep, voffB);
        PG8_WAIT_V(6); PG8_BAR;
    } else {
        PG8_STAGE(PG8_SB(0, 0), cB, voffB); PG8_STAGE(PG8_SA(0, 0), cA, voffA); PG8_STAGE(PG8_SB(0, 1), cB + hstep, voffB); PG8_STAGE(PG8_SA(0, 1), cA + hstep, voffA);
        if (wr == 1) PG8_BAR;
        PG8_WAIT_V(4); PG8_BAR;
        PG8_STAGE(PG8_SB(1, 0), cB + kstep, voffB); PG8_STAGE(PG8_SA(1, 0), cA + kstep, voffA); PG8_STAGE(PG8_SB(1, 1), cB + hstep + kstep, voffB);
        PG8_WAIT_V(6); PG8_BAR;
    }
    for (;;) {
        const bool has_next = S.next(ui + 1, nxt);
        const char* nA = has_next ? (const char*)g.A + (size_t)nxt.pm * tstep : cA; const char* nB = has_next ? (const char*)g.Bt + (size_t)nxt.pn * tstep : cB;
        for (int t = 0; t < nt; t += 2) {
            const bool last = (t == nt - 2);
            const char* a1 = cA + (size_t)(t + 1) * kstep;
            const char* a2 = last ? nA : cA + (size_t)(t + 2) * kstep; const char* b2 = last ? nB : cB + (size_t)(t + 2) * kstep;
            const char* a3 = a2 + kstep; const char* b3 = b2 + kstep;
            if (last && has_next) S.a_ready(nxt);
            if constexpr (SP2) {
            PG8_LDB(B0, 0, 0); PG8_LDB(B1, 0, 1); PG8_SCHED; PG8_LDA(At, 0, 0); PG8_STAGE(PG8_SA(1, 1), a1 + hstep, voffA);
            PG8_WAIT_V(8); PG8_WAIT_L(0); PG8_BAR; PG8_MMA(0, 0, At, B0); PG8_MMA(0, 1, At, B1); PG8_BAR; PG8_SCHED;
            PG8_LDA(At, 0, 1); PG8_STAGE(PG8_SB(0, 0), b2, voffB); PG8_STAGE(PG8_SB(0, 1), b2 + hstep, voffB); PG8_STAGE(PG8_SA(0, 0), a2, voffA);
            PG8_WAIT_V(8); PG8_WAIT_L(0); PG8_BAR; PG8_MMA(1, 0, At, B0); PG8_MMA(1, 1, At, B1); PG8_BAR; PG8_SCHED;
            PG8_LDB(B0, 1, 0); PG8_LDB(B1, 1, 1); PG8_SCHED; PG8_LDA(At, 1, 0); PG8_STAGE(PG8_SA(0, 1), a2 + hstep, voffA);
            PG8_WAIT_V(8); PG8_WAIT_L(0); PG8_BAR; PG8_MMA(0, 0, At, B0); PG8_MMA(0, 1, At, B1); PG8_BAR; PG8_SCHED;
            PG8_LDA(At, 1, 1); PG8_STAGE(PG8_SB(1, 0), b3, voffB); PG8_STAGE(PG8_SB(1, 1), b3 + hstep, voffB); PG8_STAGE(PG8_SA(1, 0), a3, voffA);
            PG8_WAIT_V(8); PG8_WAIT_L(0); PG8_BAR; PG8_MMA(1, 0, At, B0); PG8_MMA(1, 1, At, B1); PG8_BAR; PG8_SCHED;
            } else {
            PG8_LDB(B0, 0, 0); PG8_SCHED; PG8_LDA(At, 0, 0); PG8_STAGE(PG8_SA(1, 1), a1 + hstep, voffA);
            PG8_WAIT_L(8); PG8_BAR; PG8_WAIT_L(0); PG8_MMA(0, 0, At, B0); PG8_BAR; PG8_SCHED;
            PG8_LDB(B1, 0, 1); PG8_STAGE(PG8_SB(0, 0), b2, voffB);
            PG8_BAR; PG8_WAIT_L(0); PG8_MMA(0, 1, At, B1); PG8_BAR;
            PG8_LDA(At, 0, 1); PG8_STAGE(PG8_SA(0, 0), a2, voffA);
            PG8_BAR; PG8_WAIT_L(0); PG8_MMA(1, 0, At, B0); PG8_BAR; PG8_SCHED;
            PG8_STAGE(PG8_SB(0, 1), b2 + hstep, voffB);
            PG8_WAIT_V(6); PG8_BAR; PG8_MMA(1, 1, At, B1); PG8_BAR;
            PG8_LDB(B0, 1, 0); PG8_SCHED; PG8_LDA(At, 1, 0); PG8_STAGE(PG8_SA(0, 1), a2 + hstep, voffA);
            PG8_WAIT_L(8); PG8_BAR; PG8_WAIT_L(0); PG8_MMA(0, 0, At, B0); PG8_BAR; PG8_SCHED;
            PG8_LDB(B1, 1, 1); PG8_STAGE(PG8_SB(1, 0), b3, voffB);
            PG8_BAR; PG8_WAIT_L(0); PG8_MMA(0, 1, At, B1); PG8_BAR;
            PG8_LDA(At, 1, 1); PG8_STAGE(PG8_SA(1, 0), a3, voffA);
            PG8_BAR; PG8_WAIT_L(0); PG8_MMA(1, 0, At, B0); PG8_BAR; PG8_SCHED;
            PG8_STAGE(PG8_SB(1, 1), b3 + hstep, voffB);
            PG8_WAIT_V(6); PG8_BAR; PG8_MMA(1, 1, At, B1); PG8_BAR;
            }
        }
        if constexpr (ALIGN_EPI) { if (wr == 0) PG8_BAR; }
        if constexpr (!Epi::AFTER_DRAIN) { E(acc, cur, wr, wc, fr, fq); S.done(cur); }
        if (!has_next) break;
#pragma unroll
        for (int a = 0; a < 2; ++a)
#pragma unroll
            for (int b = 0; b < 2; ++b)
#pragma unroll
                for (int m = 0; m < 4; ++m)
#pragma unroll
                    for (int n = 0; n < 2; ++n) acc[a][b][m][n] = (f32x4){0.f, 0.f, 0.f, 0.f};
        cur = nxt; cA = nA; cB = nB; ++ui;
        if constexpr (ALIGN_EPI) { if (wr == 1) PG8_BAR; }
    }
    PG8_WAIT_V(0);
    if constexpr (!ALIGN_EPI) { if (wr == 0) PG8_BAR; }
    PG8_BAR;
    if constexpr (Epi::AFTER_DRAIN) { E.fused(acc, cur, wr, wc, fr, fq, lds, wid, lane); S.done(cur); }
#undef PG8_SA
#undef PG8_SB
#undef PG8_STAGE
#undef PG8_LDA
#undef PG8_LDB
#undef PG8_MMA
#undef PG8_WAIT_V
#undef PG8_WAIT_L
#undef PG8_BAR
#undef PG8_SCHED
}
}

#ifndef PG8_SP2
#define PG8_SP2 true
#endif
#ifndef PG8_ALIGN
#define PG8_ALIGN true
#endif

#include <hip/hip_bf16.h>
#include <cmath>
namespace attn2 {
using bf16=__hip_bfloat16;
using bf16x8=__attribute__((ext_vector_type(8)))short;
using s16x4=__attribute__((ext_vector_type(4)))short;
using f32x16=__attribute__((ext_vector_type(16)))float;
using u32x4=__attribute__((ext_vector_type(4)))unsigned;
constexpr int SEQ=8192,D=64,DM=1024;
constexpr int NW=8,QBLK=32,QB=QBLK*NW,KVBLK=64,NQB=SEQ/QB;
constexpr int ATTN_PITCH=DM, ATTN_UNIT_ROWS=QB;
__device__ __forceinline__ int crow(int r,int hi){return (r&3)+8*(r>>2)+4*hi;}
#define SBAR() __builtin_amdgcn_sched_barrier(0)
__device__ __forceinline__ void cmask(f32x16&p0,f32x16&p1,int jb,int qrel,int hi){
  const float NEG=-INFINITY; int kb=64*jb+4*hi;
  #pragma unroll
  for(int r=0;r<16;++r){int kv=kb+(r&3)+8*(r>>2); if(kv>qrel)p0[r]=NEG; if(kv+32>qrel)p1[r]=NEG;}
}

constexpr int NSLOT=3, SLOTB=8192, VSLOTB=16384;
constexpr int LDS_K=0, LDS_V=NSLOT*SLOTB, LDS_WS=LDS_V+NSLOT*VSLOTB, LDS_OST=LDS_WS+NW*64*4, LDS_BYTES=LDS_OST+NW*4096;
constexpr float C2=0.125f*1.4426950408889634f;
__device__ __forceinline__ void glds16(const void*gsrc,unsigned lds_dst){unsigned keep;
  asm volatile("s_mov_b32 %0, m0\n\ts_mov_b32 m0, %2\n\ts_nop 0\n\tglobal_load_lds_dwordx4 %1, off\n\ts_mov_b32 m0, %0":"=&s"(keep):"v"(gsrc),"s"(lds_dst):"memory");}
__device__ __forceinline__ float max3f(float a,float b,float c){float r;asm("v_max3_f32 %0, %1, %2, %3":"=v"(r):"v"(a),"v"(b),"v"(c));return r;}
__device__ __forceinline__ float max2f(float a,float b){float r;asm("v_max_f32_e32 %0, %1, %2":"=v"(r):"v"(a),"v"(b));return r;}
__device__ __forceinline__ float fadd_s(float a,float b){float r;asm("v_add_f32_e32 %0, %1, %2":"=v"(r):"v"(a),"v"(b));return r;}
__device__ __forceinline__ float fsub_s(float a,float b){float r;asm("v_sub_f32_e32 %0, %1, %2":"=v"(r):"v"(a),"v"(b));return r;}
typedef float f32x2_t __attribute__((ext_vector_type(2))); typedef __bf16 bf16x2_t __attribute__((ext_vector_type(2)));
__device__ __forceinline__ unsigned cvtpk_s(float lo,float hi){f32x2_t v={lo,hi};bf16x2_t b=__builtin_convertvector(v,bf16x2_t);return __builtin_bit_cast(unsigned,b);}
#define WAIT_BAR(N) asm volatile("s_waitcnt vmcnt(" #N ") lgkmcnt(0)\n\ts_barrier":::"memory")

__device__ __forceinline__ void qkt(f32x16&p0,f32x16&p1,const char*Kslot,const bf16x8*qr,const f32x16&negm,int r32,int hi){
  const char*kb=Kslot+hi*1024+r32*16;
  #pragma unroll
  for(int d0=0;d0<4;++d0){
    const bf16x8 b0=*reinterpret_cast<const bf16x8*>(kb+d0*2048);
    const bf16x8 b1=*reinterpret_cast<const bf16x8*>(kb+d0*2048+512);
    if(d0==0){p0=__builtin_amdgcn_mfma_f32_32x32x16_bf16(b0,qr[0],negm,0,0,0);p1=__builtin_amdgcn_mfma_f32_32x32x16_bf16(b1,qr[0],negm,0,0,0);}
    else{p0=__builtin_amdgcn_mfma_f32_32x32x16_bf16(b0,qr[d0],p0,0,0,0);p1=__builtin_amdgcn_mfma_f32_32x32x16_bf16(b1,qr[d0],p1,0,0,0);}}
}
typedef __attribute__((address_space(3))) const char* lds_cptr;
typedef short v4i16_t __attribute__((ext_vector_type(4)));
__device__ __forceinline__ void kload8(bf16x8*kf,lds_cptr kp){
  kf[0]=*(const __attribute__((address_space(3))) bf16x8*)(kp);      kf[1]=*(const __attribute__((address_space(3))) bf16x8*)(kp+512);
  kf[2]=*(const __attribute__((address_space(3))) bf16x8*)(kp+2048); kf[3]=*(const __attribute__((address_space(3))) bf16x8*)(kp+2560);
  kf[4]=*(const __attribute__((address_space(3))) bf16x8*)(kp+4096); kf[5]=*(const __attribute__((address_space(3))) bf16x8*)(kp+4608);
  kf[6]=*(const __attribute__((address_space(3))) bf16x8*)(kp+6144); kf[7]=*(const __attribute__((address_space(3))) bf16x8*)(kp+6656);
}
__device__ __forceinline__ void kload2(bf16x8*kf,lds_cptr kp,int j){ kf[2*j]=*(const __attribute__((address_space(3))) bf16x8*)(kp+j*2048); kf[2*j+1]=*(const __attribute__((address_space(3))) bf16x8*)(kp+j*2048+512); }
__device__ __forceinline__ s16x4 vtr(lds_cptr p){ return __builtin_bit_cast(s16x4,__builtin_amdgcn_ds_read_tr16_b64_v4i16((__attribute__((address_space(3))) v4i16_t*)p)); }
__device__ __forceinline__ float rowmax(const f32x16&p0,const f32x16&p1){
  float a=max3f(p0[0],p0[1],p1[0]),b=max3f(p0[2],p0[3],p1[1]);a=max3f(a,p1[2],p1[3]);
  #pragma unroll
  for(int r=4;r<16;r+=4){a=max3f(a,p0[r],p0[r+1]);b=max3f(b,p0[r+2],p0[r+3]);a=max3f(a,p1[r],p1[r+1]);b=max3f(b,p1[r+2],p1[r+3]);}
  const float m=max2f(a,b);
  auto rr=__builtin_amdgcn_permlane32_swap(__float_as_uint(m),__float_as_uint(m),false,false);
  return max2f(__uint_as_float(rr[0]),__uint_as_float(rr[1]));
}
__device__ __forceinline__ void pv(f32x16*o,int vb,bf16x8 pa0,bf16x8 pa1,bf16x8 pa2,bf16x8 pa3){
  #pragma unroll
  for(int d0=0;d0<4;++d0){s16x4 lo[4],hi[4];
    #pragma unroll
    for(int ks=0;ks<4;++ks){
      asm volatile("ds_read_b64_tr_b16 %0,%1 offset:%c2":"=&v"(lo[ks]):"v"(vb),"i"(d0*4096+ks*1024):"memory");
      asm volatile("ds_read_b64_tr_b16 %0,%1 offset:%c2":"=&v"(hi[ks]):"v"(vb),"i"(d0*4096+ks*1024+512):"memory");}
    asm volatile("s_waitcnt lgkmcnt(0)":::"memory");SBAR();
    #define PK(k) (bf16x8){lo[k][0],lo[k][1],lo[k][2],lo[k][3],hi[k][0],hi[k][1],hi[k][2],hi[k][3]}
    o[d0]=__builtin_amdgcn_mfma_f32_32x32x16_bf16(pa0,PK(0),o[d0],0,0,0);
    o[d0]=__builtin_amdgcn_mfma_f32_32x32x16_bf16(pa1,PK(1),o[d0],0,0,0);
    o[d0]=__builtin_amdgcn_mfma_f32_32x32x16_bf16(pa2,PK(2),o[d0],0,0,0);
    o[d0]=__builtin_amdgcn_mfma_f32_32x32x16_bf16(pa3,PK(3),o[d0],0,0,0);
    #undef PK
  }
}

#ifndef ATTN_STORE16
#define ATTN_STORE16(p,v) (*(u32x4*)(p)=(v))
#endif
template<int THRL> __device__ __forceinline__ void attn_unit(long rowbase,int qkcol,int vcol,int qb,const bf16*Q,const bf16*__restrict__ K,const bf16*__restrict__ V,bf16*O,char*shm){
  const int tid=threadIdx.x,lane=tid&63,r32=lane&31,hi=lane>>5; const int wid=__builtin_amdgcn_readfirstlane(tid>>6);
  const int q0=qb*QB;
  const bf16*Qw=Q+(rowbase+q0+wid*QBLK)*DM+qkcol;
  const bf16*Kh=K+rowbase*DM+qkcol,*Vh=V+rowbase*DM+vcol;
  const unsigned lds0=(unsigned)(uintptr_t)shm;
  float*wsf=(float*)(shm+LDS_WS)+wid*64;
  const bf16*ksrc=Kh+(long)lane*DM+wid*8;
  const bf16*vsrc=Vh+(long)(16*(wid&3)+(lane>>2))*DM+(wid>>2)*32+(lane&3)*8;
  const unsigned kdst=lds0+LDS_K+wid*1024, vdst=lds0+LDS_V+wid*1024;
  #define DMA_K(t,slot) glds16(ksrc+(long)(t)*KVBLK*DM,(unsigned)__builtin_amdgcn_readfirstlane(kdst+(slot)))
  #define DMA_V(t,slot) do{ glds16(vsrc+(long)(t)*KVBLK*DM,(unsigned)__builtin_amdgcn_readfirstlane(vdst+2*(slot))); glds16(vsrc+64+(long)(t)*KVBLK*DM,(unsigned)__builtin_amdgcn_readfirstlane(vdst+2*(slot)+8192)); }while(0)
  const int vb0=(int)(lds0+LDS_V)+((lane>>4)&1)*32+(lane&3)*8+(4*hi+((lane&15)>>2))*64;
  const char*Kbase=shm+LDS_K; bf16x8 kf[8];
  const lds_cptr shm3=(lds_cptr)shm; const lds_cptr kp0=shm3+LDS_K+hi*1024+r32*16; const lds_cptr vp0=shm3+LDS_V+((lane>>4)&1)*32+(lane&3)*8+(4*hi+((lane&15)>>2))*64;
  const int NT=(q0+QB)/KVBLK;
  DMA_K(0,0);DMA_V(0,0);DMA_K(1,SLOTB);
  bf16x8 qr[4];
  #pragma unroll
  for(int d0=0;d0<4;++d0)qr[d0]=*reinterpret_cast<const bf16x8*>(&Qw[(long)r32*DM+d0*16+hi*8]);
  float mhat=0.f,l_reg=0.f;f32x16 o[4];o[0]=f32x16{};o[1]=f32x16{};o[2]=f32x16{};o[3]=f32x16{};f32x16 negm=f32x16{};asm volatile("":"+v"(negm));
  const int qrel=wid*QBLK+r32;
  #define CMASK(P0,P1,t) do{int jb_=(t)-(NT-4); if(jb_>=0)cmask(P0,P1,jb_,qrel,hi);}while(0)
  bool resc=false;
  #define START(P0,P1) do{ const float rm=rowmax(P0,P1); resc=false; \
    { const float dl=rm; mhat=fadd_s(mhat,dl); \
      _Pragma("unroll") for(int r=0;r<16;++r){P0[r]=fsub_s(P0[r],dl);P1[r]=fsub_s(P1[r],dl);} \
      _Pragma("unroll") for(int r=0;r<16;++r)negm[r]=-mhat; asm volatile("":"+v"(negm)); } \
    _Pragma("unroll") for(int r=0;r<16;++r)P0[r]=__builtin_amdgcn_exp2f(P0[r]); }while(0)
  #define RESC() do{ if(resc){ asm volatile("s_waitcnt lgkmcnt(0)":::"memory"); \
      _Pragma("unroll") for(int d_=0;d_<4;++d_) _Pragma("unroll") for(int r=0;r<16;++r)o[d_][r]*=wsf[crow(r,hi)]; } }while(0)
  f32x16 pA0,pA1,pB0,pB1;
  int sl_prev=0,sl_cur=0,sl_next=SLOTB;
  #define ROT() do{sl_prev=sl_cur;sl_cur=sl_next;sl_next=(sl_next==(NSLOT-1)*SLOTB)?0:sl_next+SLOTB;}while(0)
  DMA_K(2,2*SLOTB);
  WAIT_BAR(4);
  qkt(pA0,pA1,Kbase,qr,negm,r32,hi);asm volatile("s_nop 15\n\ts_nop 7":"+v"(pA0),"+v"(pA1));CMASK(pA0,pA1,0);
  START(pA0,pA1);
  _Pragma("unroll") for(int r=0;r<16;++r)pA1[r]=__builtin_amdgcn_exp2f(pA1[r]);
  WAIT_BAR(0);
  DMA_K(3,0);DMA_V(1,SLOTB);
  ROT();
  kload8(kf,kp0+sl_cur);
  WAIT_BAR(3);
  s16x4 vlo[16],vhi[16]; u32x4 pw0,pw1,pw2,pw3;
  #define PKW(P,B) cvtpk_s(P[B],P[B+1])
  #define PAF(k) __builtin_bit_cast(bf16x8,pw##k)
  #define VFR(i) (bf16x8){vlo[i][0],vlo[i][1],vlo[i][2],vlo[i][3],vhi[i][0],vhi[i][1],vhi[i][2],vhi[i][3]}
  #define PIN(x) asm volatile("":"+v"(x))
  #define MX3(a,b,c) __builtin_fmaxf(__builtin_fmaxf((a),(b)),(c))
  #define GAPA(MF,A0,A1,A2,A3,W0,W1,PW) do{ MF; sacc+=A0; sacc+=A1; sacc+=A2; sacc+=A3; PIN(sacc); W0; W1; PIN(PW); SBAR(); }while(0)
  #define EX(v) __builtin_amdgcn_exp2f(v)
  #define GAPB(MF,X,B) do{ MF; X[B]=EX(X[B]); X[B+1]=EX(X[B+1]); PIN(X); SBAR(); }while(0)
  #define VRD(i) do{ vlo[i]=vtr(vp_+(((i)&3)*4096+((i)>>2)*1024)); vhi[i]=vtr(vp_+(((i)&3)*4096+((i)>>2)*1024+512)); }while(0)
  #define KRD(G,j) do{ if(G){ kload2(kf,kp0+sl_next,j); SBAR(); } }while(0)
  #define STEP(C0,C1,P0,P1,t,GK,GV,GL) do{ SBAR(); \
    const lds_cptr vp_=vp0+2*sl_prev; \
    VRD(0); SBAR(); float sacc=(P0[0]+P0[1]); GAPA(C0=__builtin_amdgcn_mfma_f32_32x32x16_bf16(kf[0],qr[0],negm,0,0,0), P0[2],P0[3],P0[4],P0[5], pw0[0]=PKW(P0,0), pw0[1]=PKW(P0,2), pw0); \
    VRD(1); SBAR(); GAPA(C1=__builtin_amdgcn_mfma_f32_32x32x16_bf16(kf[1],qr[0],negm,0,0,0), P0[6],P0[7],P0[8],P0[9], pw0[2]=PKW(P0,4), pw0[3]=PKW(P0,6), pw0); \
    VRD(2); SBAR(); GAPA(C0=__builtin_amdgcn_mfma_f32_32x32x16_bf16(kf[2],qr[1],C0,0,0,0), P0[10],P0[11],P0[12],P0[13], pw1[0]=PKW(P0,8), pw1[1]=PKW(P0,10), pw1); \
    VRD(3); SBAR(); GAPA(C1=__builtin_amdgcn_mfma_f32_32x32x16_bf16(kf[3],qr[1],C1,0,0,0), P0[14],P0[15],P1[0],P1[1], pw1[2]=PKW(P0,12), pw1[3]=PKW(P0,14), pw1); \
    VRD(4); SBAR(); GAPA(C0=__builtin_amdgcn_mfma_f32_32x32x16_bf16(kf[4],qr[2],C0,0,0,0), P1[2],P1[3],P1[4],P1[5], pw2[0]=PKW(P1,0), pw2[1]=PKW(P1,2), pw2); \
    VRD(5); SBAR(); GAPA(C1=__builtin_amdgcn_mfma_f32_32x32x16_bf16(kf[5],qr[2],C1,0,0,0), P1[6],P1[7],P1[8],P1[9], pw2[2]=PKW(P1,4), pw2[3]=PKW(P1,6), pw2); \
    VRD(6); SBAR(); GAPA(C0=__builtin_amdgcn_mfma_f32_32x32x16_bf16(kf[6],qr[3],C0,0,0,0), P1[10],P1[11],P1[12],P1[13], pw3[0]=PKW(P1,8), pw3[1]=PKW(P1,10), pw3); \
    VRD(7); SBAR(); GAPA(C1=__builtin_amdgcn_mfma_f32_32x32x16_bf16(kf[7],qr[3],C1,0,0,0), P1[14],P1[15],0.f,0.f, pw3[2]=PKW(P1,12), pw3[3]=PKW(P1,14), pw3); \
    l_reg+=sacc; \
    if(GK){DMA_K((t)+3,sl_cur);} if(GV){DMA_V((t)+1,sl_next);} \
    CMASK(C0,C1,t); \
    { float a=MX3(C0[0],C0[1],C1[0]),b=MX3(C0[2],C0[3],C1[1]); a=MX3(a,C1[2],C1[3]); \
      _Pragma("unroll") for(int r=4;r<16;r+=4){a=MX3(a,C0[r],C0[r+1]);b=MX3(b,C0[r+2],C0[r+3]);a=MX3(a,C1[r],C1[r+1]);b=MX3(b,C1[r+2],C1[r+3]);} \
      float rm=__builtin_fmaxf(a,b); { auto rr=__builtin_amdgcn_permlane32_swap(__float_as_uint(rm),__float_as_uint(rm),false,false); rm=__builtin_fmaxf(__uint_as_float(rr[0]),__uint_as_float(rr[1])); } \
      resc=false; \
      if(__builtin_expect(__any(rm>(float)THRL),0)){ const float dl=__builtin_fmaxf(rm,0.f); mhat+=dl; \
        _Pragma("unroll") for(int r=0;r<16;++r){C0[r]-=dl;C1[r]-=dl;} \
        _Pragma("unroll") for(int r=0;r<16;++r)negm[r]=-mhat; asm volatile("":"+v"(negm)); \
        const float f=__builtin_amdgcn_exp2f(-dl); l_reg*=f; if(hi==0)wsf[r32]=f; resc=true; } } \
    SBAR(); \
    VRD(8); SBAR(); GAPB(o[0]=__builtin_amdgcn_mfma_f32_32x32x16_bf16(PAF(0),VFR(0),o[0],0,0,0), C0,0); \
    VRD(9); SBAR(); GAPB(o[1]=__builtin_amdgcn_mfma_f32_32x32x16_bf16(PAF(0),VFR(1),o[1],0,0,0), C0,2); \
    VRD(10); SBAR(); GAPB(o[2]=__builtin_amdgcn_mfma_f32_32x32x16_bf16(PAF(0),VFR(2),o[2],0,0,0), C0,4); \
    VRD(11); SBAR(); GAPB(o[3]=__builtin_amdgcn_mfma_f32_32x32x16_bf16(PAF(0),VFR(3),o[3],0,0,0), C0,6); \
    VRD(12); SBAR(); GAPB(o[0]=__builtin_amdgcn_mfma_f32_32x32x16_bf16(PAF(1),VFR(4),o[0],0,0,0), C0,8); \
    VRD(13); SBAR(); GAPB(o[1]=__builtin_amdgcn_mfma_f32_32x32x16_bf16(PAF(1),VFR(5),o[1],0,0,0), C0,10); \
    VRD(14); SBAR(); GAPB(o[2]=__builtin_amdgcn_mfma_f32_32x32x16_bf16(PAF(1),VFR(6),o[2],0,0,0), C0,12); \
    VRD(15); SBAR(); GAPB(o[3]=__builtin_amdgcn_mfma_f32_32x32x16_bf16(PAF(1),VFR(7),o[3],0,0,0), C0,14); \
    KRD(GL,0); GAPB(o[0]=__builtin_amdgcn_mfma_f32_32x32x16_bf16(PAF(2),VFR(8),o[0],0,0,0), C1,0); \
    KRD(GL,1); GAPB(o[1]=__builtin_amdgcn_mfma_f32_32x32x16_bf16(PAF(2),VFR(9),o[1],0,0,0), C1,2); \
    KRD(GL,2); GAPB(o[2]=__builtin_amdgcn_mfma_f32_32x32x16_bf16(PAF(2),VFR(10),o[2],0,0,0), C1,4); \
    KRD(GL,3); GAPB(o[3]=__builtin_amdgcn_mfma_f32_32x32x16_bf16(PAF(2),VFR(11),o[3],0,0,0), C1,6); \
    GAPB(o[0]=__builtin_amdgcn_mfma_f32_32x32x16_bf16(PAF(3),VFR(12),o[0],0,0,0), C1,8); \
    GAPB(o[1]=__builtin_amdgcn_mfma_f32_32x32x16_bf16(PAF(3),VFR(13),o[1],0,0,0), C1,10); \
    GAPB(o[2]=__builtin_amdgcn_mfma_f32_32x32x16_bf16(PAF(3),VFR(14),o[2],0,0,0), C1,12); \
    GAPB(o[3]=__builtin_amdgcn_mfma_f32_32x32x16_bf16(PAF(3),VFR(15),o[3],0,0,0), C1,14); \
    }while(0)
  int t=1;
  #undef CMASK
  #define CMASK(P0,P1,t) do{}while(0)
  for(;t+5<NT;t+=2){
    STEP(pB0,pB1,pA0,pA1,t,true,true,true);     WAIT_BAR(3); RESC(); ROT();
    STEP(pA0,pA1,pB0,pB1,t+1,true,true,true);   WAIT_BAR(3); RESC(); ROT();
  }
  #undef CMASK
  #define CMASK(P0,P1,t) do{int jb_=(t)-(NT-4); if(jb_>=0)cmask(P0,P1,jb_,qrel,hi);}while(0)
  #define ENDW(tt) do{ if((tt)+3<NT){WAIT_BAR(3);} else if((tt)+2<NT){WAIT_BAR(2);} else {WAIT_BAR(0);} }while(0)
  for(;t+1<NT;t+=2){
    STEP(pB0,pB1,pA0,pA1,t,(t+3<NT),(t+1<NT),(t+1<NT));       ENDW(t);   RESC(); ROT();
    STEP(pA0,pA1,pB0,pB1,t+1,(t+4<NT),(t+2<NT),(t+2<NT));     ENDW(t+1); RESC(); ROT();
  }
  STEP(pB0,pB1,pA0,pA1,NT-1,false,false,false); RESC();
  { float sacc=pB0[0]+pB0[1]; _Pragma("unroll") for(int r=2;r<16;++r)sacc+=pB0[r]; _Pragma("unroll") for(int r=0;r<16;++r)sacc+=pB1[r]; l_reg+=sacc;
    pw0=(u32x4){PKW(pB0,0),PKW(pB0,2),PKW(pB0,4),PKW(pB0,6)};pw1=(u32x4){PKW(pB0,8),PKW(pB0,10),PKW(pB0,12),PKW(pB0,14)};pw2=(u32x4){PKW(pB1,0),PKW(pB1,2),PKW(pB1,4),PKW(pB1,6)};pw3=(u32x4){PKW(pB1,8),PKW(pB1,10),PKW(pB1,12),PKW(pB1,14)};
    SBAR(); pv(o,vb0+2*sl_cur,PAF(0),PAF(1),PAF(2),PAF(3)); }
  #undef PKW
  #undef PAF
  #undef VFR
  #undef PIN
  #undef MX3
  #undef GAPA
  #undef GAPB
  #undef EX
  #undef VRD
  #undef KRD
  #undef STEP
  #undef ENDW
  {auto rr=__builtin_amdgcn_permlane32_swap(__float_as_uint(l_reg),__float_as_uint(l_reg),false,false);l_reg=__uint_as_float(rr[0])+__uint_as_float(rr[1]);}
  if(hi==0)wsf[32+r32]=l_reg;asm volatile("s_waitcnt lgkmcnt(0)":::"memory");
  float rli[16];
  #pragma unroll
  for(int r=0;r<16;++r)rli[r]=__builtin_amdgcn_rcpf(wsf[32+crow(r,hi)]);
  bf16*Ow=O+(rowbase+q0+wid*QBLK)*DM+vcol;
  { bf16*stg=(bf16*)(shm+LDS_OST)+wid*2048;
    #pragma unroll
    for(int hh=0;hh<2;++hh){
      #pragma unroll
      for(int r=0;r<16;++r){const int orow=crow(r,hi);
        #pragma unroll
        for(int d0=0;d0<2;++d0)stg[orow*64+d0*32+r32]=__float2bfloat16(o[2*hh+d0][r]*rli[r]);}
      asm volatile("s_waitcnt lgkmcnt(0)":::"memory");
      #pragma unroll
      for(int i=0;i<4;++i){const int row=i*8+(lane>>3),ch=lane&7; const u32x4 v=*(const u32x4*)(stg+row*64+ch*8); ATTN_STORE16(Ow+(long)row*DM+hh*64+ch*8,v);}
      asm volatile("s_waitcnt lgkmcnt(0)":::"memory"); } }
  asm volatile("s_waitcnt lgkmcnt(0)\n\ts_barrier":::"memory");
  #undef DMA_K
  #undef DMA_V
  #undef CMASK
  #undef START
  #undef RESC
  #undef ROT
}
constexpr int ATTN_LDS_BYTES=LDS_BYTES;
#ifndef ATTN_REPS
#define ATTN_REPS 1
#endif
struct AttnTensors { const bf16* Q; const bf16* K; const bf16* V; bf16* O1; bf16* O2; };
struct AttnUnit { int b, mh, vo, s, qb; };
struct DealOrder {
  int vcu;
  __device__ __forceinline__ explicit DealOrder(int v):vcu(v){}
  __device__ __forceinline__ bool next(int i_,AttnUnit&u)const{ if(i_>=8*ATTN_REPS)return false; const int i=i_&7; const int bh=vcu>>3,h=bh&7,sub=vcu&7,s=sub>>2,qt=sub&3,j=qt+4*(i>>1);
    u.b=bh>>3; u.mh=(s*8+h)*64; u.vo=h*128; u.s=s; u.qb=(i&1)?31-j:j; return true; }
};
template<class Sched,int THRL=8> __device__ __forceinline__ void attn_phase(char*lds,const AttnTensors&T,const Sched&S){
  AttnUnit u;
  for(int i=0;S.next(i,u);++i){ attn_unit<THRL>((long)u.b*SEQ,u.mh,u.vo,u.qb,T.Q,T.K,T.V,u.s?T.O2:T.O1,lds); }
}
#undef SBAR
#undef WAIT_BAR
}


#define GAS __attribute__((address_space(1)))
#define LAS __attribute__((address_space(3)))
typedef unsigned v4u __attribute__((ext_vector_type(4)));
typedef float f32x4 __attribute__((ext_vector_type(4)));
typedef short bf16x8 __attribute__((ext_vector_type(8)));
typedef GAS unsigned gu32;
typedef GAS unsigned long long gu64;
#define RLX_AGENT __ATOMIC_RELAXED, __HIP_MEMORY_SCOPE_AGENT
#define LDS_WAIT() asm volatile("s_waitcnt lgkmcnt(0)" ::: "memory")
#define VM_WAIT() asm volatile("s_waitcnt vmcnt(0)" ::: "memory")
__device__ __forceinline__ unsigned long long rt() { return __builtin_amdgcn_s_memrealtime(); }

#define XB_TMO      128
#define XB_XCNT(j)  (256  + 64 * (j))
#define XB_XSUB(j)  (1280 + 64 * (j))
#define XB_XGEN(j)  (2304 + 64 * (j))
#define XB_TOP      3328
#define XB_TOPGEN   3392
#define XCD_BAR_WORDS 3456
#define XB_SPIN_CAP (1u << 18)

__device__ __forceinline__ unsigned xb_ld(unsigned* p)              { return __hip_atomic_load(p, __ATOMIC_RELAXED, __HIP_MEMORY_SCOPE_AGENT); }
__device__ __forceinline__ unsigned xb_add(unsigned* p, unsigned v) { return __hip_atomic_fetch_add(p, v, __ATOMIC_RELAXED, __HIP_MEMORY_SCOPE_AGENT); }
__device__ __forceinline__ unsigned xb_xcc_id() { return (unsigned)__builtin_amdgcn_s_getreg((3 << 11) | 20) & 0xFu; }
#define XB_SPIN(cond, bar) do { unsigned _sp = 0; while (cond) { __builtin_amdgcn_s_sleep(1); \
    if ((++_sp & 255u) == 0u) { if (xb_ld(&(bar)[XB_TMO])) break; if (_sp > XB_SPIN_CAP) { atomicAdd(&(bar)[XB_TMO], 1u); break; } } } } while (0)

struct XcdBarrier {
    unsigned* bar; unsigned x;
    volatile LAS unsigned* st;
};

__device__ __forceinline__ XcdBarrier xcd_barrier_post(unsigned* bar, volatile LAS unsigned* st) {
    XcdBarrier b; b.bar = bar; b.x = xb_xcc_id(); b.st = st;
    if (threadIdx.x == 0) (void)xb_add(&bar[XB_XCNT(b.x)], 1u);
    return b;
}
__device__ __forceinline__ void xcd_barrier_complete(unsigned* bar, unsigned x, unsigned& nloc, unsigned& nx) {
    const unsigned G = gridDim.x * gridDim.y * gridDim.z;
    unsigned sum, cnt, mine, sp = 0u;
    for (;;) {
        sum = 0u; cnt = 0u; mine = 0u;
#pragma unroll
        for (unsigned j = 0; j < 16; ++j) { const unsigned c = xb_ld(&bar[XB_XCNT(j)]); sum += c; cnt += (c > 0u) ? 1u : 0u; mine = (j == x) ? c : mine; }
        if (sum == G) break;
        __builtin_amdgcn_s_sleep(1);
        if ((++sp & 255u) == 0u) { if (xb_ld(&bar[XB_TMO])) break; if (sp > XB_SPIN_CAP) { atomicAdd(&bar[XB_TMO], 1u); break; } }
    }
    nloc = mine > 0u ? mine : 1u; nx = cnt > 0u ? cnt : 1u;
}

__device__ __forceinline__ void xcd_barrier(const XcdBarrier& b) {
    asm volatile("s_waitcnt vmcnt(0)" ::: "memory");
    __syncthreads();
    if (threadIdx.x == 0) {
        unsigned* bar = b.bar;
        __builtin_amdgcn_s_waitcnt(0);
        unsigned nloc = b.st[0], nx = b.st[1];
        if (nloc == 0u) { xcd_barrier_complete(bar, b.x, nloc, nx); b.st[0] = nloc; b.st[1] = nx; }
        const unsigned old = xb_add(&bar[XB_XSUB(b.x)], 1u);
        const unsigned gen = old / nloc;
        if (old + 1u == (gen + 1u) * nloc) {
            __builtin_amdgcn_fence(__ATOMIC_RELEASE, "agent");
            asm volatile("s_waitcnt vmcnt(0)" ::: "memory");
            const unsigned og = xb_add(&bar[XB_TOP], 1u);
            const unsigned tg = og / nx;
            if (og + 1u == (tg + 1u) * nx) xb_add(&bar[XB_TOPGEN], 1u);
            else XB_SPIN(xb_ld(&bar[XB_TOPGEN]) == tg, bar);
            __builtin_amdgcn_fence(__ATOMIC_ACQUIRE, "agent");
            xb_add(&bar[XB_XGEN(b.x)], 1u);
            asm volatile("s_waitcnt vmcnt(0)" ::: "memory");
        } else {
            XB_SPIN(xb_ld(&bar[XB_XGEN(b.x)]) == gen, bar);
            __builtin_amdgcn_fence(__ATOMIC_ACQUIRE, "agent");
            asm volatile("s_waitcnt vmcnt(0)" ::: "memory");
        }
    }
    __syncthreads();
}

namespace pg8 {
__device__ __forceinline__ float fast_sigmoid(float v) { return __builtin_amdgcn_rcpf(1.0f + __builtin_amdgcn_exp2f(-1.4426950408889634f * v)); }
__device__ __forceinline__ void st8(bf16_t* p, const f32x4& v0, const f32x4& v1) {
    u32x4 w; w.x = cvt_pk_bf16(v0[0], v0[1]); w.y = cvt_pk_bf16(v0[2], v0[3]); w.z = cvt_pk_bf16(v1[0], v1[1]); w.w = cvt_pk_bf16(v1[2], v1[3]); *(u32x4*)p = w; }
struct EpiProj {
    static constexpr bool PERM = true, AFTER_DRAIN = false;
    bf16_t *U, *Q, *Kb, *V, *GC, *GA; const float* rope;
    __device__ __forceinline__ void operator()(const f32x4 (&acc)[2][2][4][2], const Unit& u, int wr, int wc, int fr, int fq) const {
        const int row0 = u.pm * BM + wr * 64 + fr, pn = u.pn;
        if (pn < 8) {
            const int col = 128 * pn + 32 * wc + 8 * fq;
#pragma unroll
            for (int ai = 0; ai < 2; ++ai)
#pragma unroll
                for (int m = 0; m < 4; ++m) { f32x4 o[2];
#pragma unroll
                    for (int n = 0; n < 2; ++n)
#pragma unroll
                        for (int i = 0; i < 4; ++i) o[n][i] = acc[ai][0][m][n][i] * fast_sigmoid(acc[ai][1][m][n][i]);
                    st8(U + (size_t)(row0 + ai * HALF + m * 16) * 1024 + col, o[0], o[1]); }
        } else if (pn < 16) {
            const int qk = (pn - 8) >> 2, head = 4 * ((pn - 8) & 3) + wc, d0 = 8 * fq;
            bf16_t* P = qk ? Kb : Q; const float sc = qk ? 1.0f : 0.18033688011112042f;
#pragma unroll
            for (int ai = 0; ai < 2; ++ai)
#pragma unroll
                for (int m = 0; m < 4; ++m) { const int row = row0 + ai * HALF + m * 16; const float* rp = rope + ((size_t)(row & 8191) * 32 + d0) * 2;
                    f32x4 o1[2], o2[2];
#pragma unroll
                    for (int n = 0; n < 2; ++n) { const f32x4 cs0 = *(const f32x4*)(rp + 8 * n), cs1 = *(const f32x4*)(rp + 8 * n + 4);
                        const float cc[4] = {cs0[0], cs0[2], cs1[0], cs1[2]}, ss[4] = {cs0[1], cs0[3], cs1[1], cs1[3]};
#pragma unroll
                        for (int i = 0; i < 4; ++i) { const float x1 = acc[ai][0][m][n][i], x2 = acc[ai][1][m][n][i];
                            o1[n][i] = (x1 * cc[i] - x2 * ss[i]) * sc; o2[n][i] = (x2 * cc[i] + x1 * ss[i]) * sc; } }
                    bf16_t* rowp = P + (size_t)row * 1024 + head * 64 + d0; st8(rowp, o1[0], o1[1]); st8(rowp + 32, o2[0], o2[1]); }
        } else if (pn < 20) {
            const int col = 256 * (pn - 16) + 32 * wc + 8 * fq;
#pragma unroll
            for (int ai = 0; ai < 2; ++ai)
#pragma unroll
                for (int m = 0; m < 4; ++m)
#pragma unroll
                    for (int bj = 0; bj < 2; ++bj) st8(V + (size_t)(row0 + ai * HALF + m * 16) * 1024 + col + bj * HALF, acc[ai][bj][m][0], acc[ai][bj][m][1]);
        } else {
            bf16_t* P = (pn >= 24) ? GA : GC; const int col = 256 * ((pn - 20) & 3) + 32 * wc + 8 * fq;
#pragma unroll
            for (int ai = 0; ai < 2; ++ai)
#pragma unroll
                for (int m = 0; m < 4; ++m)
#pragma unroll
                    for (int bj = 0; bj < 2; ++bj) { f32x4 o[2];
#pragma unroll
                        for (int n = 0; n < 2; ++n)
#pragma unroll
                            for (int i = 0; i < 4; ++i) o[n][i] = fast_sigmoid(acc[ai][bj][m][n][i]);
                        st8(P + (size_t)(row0 + ai * HALF + m * 16) * 1024 + col + bj * HALF, o[0], o[1]); }
        }
    }
};
template <int MODE> struct EpiPlain {
    static constexpr bool PERM = true, AFTER_DRAIN = false;
    bf16_t* O; int ldc; const float* bias; const bf16_t* G;
    __device__ __forceinline__ void operator()(const f32x4 (&acc)[2][2][4][2], const Unit& u, int wr, int wc, int fr, int fq) const {
        const int row0 = u.pm * BM + wr * 64 + fr, col0 = u.pn * BM + wc * 32 + 8 * fq;
        f32x4 bv[2][2];
        if (MODE == 1) {
#pragma unroll
            for (int bj = 0; bj < 2; ++bj)
#pragma unroll
                for (int n = 0; n < 2; ++n) bv[bj][n] = *(const f32x4*)(bias + col0 + bj * HALF + 4 * n); }
#pragma unroll
        for (int ai = 0; ai < 2; ++ai)
#pragma unroll
            for (int m = 0; m < 4; ++m) { const size_t off = (size_t)(row0 + ai * HALF + m * 16) * ldc + col0;
#pragma unroll
                for (int bj = 0; bj < 2; ++bj) { f32x4 v0 = acc[ai][bj][m][0], v1 = acc[ai][bj][m][1];
                    if (MODE == 1) { const u32x4 g = *(const u32x4*)(G + off + bj * HALF);
                        v0 = v0 + bv[bj][0]; v1 = v1 + bv[bj][1];
                        v0[0] *= __uint_as_float(g.x << 16); v0[1] *= __uint_as_float(g.x & 0xffff0000u); v0[2] *= __uint_as_float(g.y << 16); v0[3] *= __uint_as_float(g.y & 0xffff0000u);
                        v1[0] *= __uint_as_float(g.z << 16); v1[1] *= __uint_as_float(g.z & 0xffff0000u); v1[2] *= __uint_as_float(g.w << 16); v1[3] *= __uint_as_float(g.w & 0xffff0000u); }
                    if (MODE == 2) {
#pragma unroll
                        for (int i = 0; i < 4; ++i) { const float a = __builtin_fmaxf(v0[i], 0.f), b = __builtin_fmaxf(v1[i], 0.f); v0[i] = a * a; v1[i] = b * b; } }
                    st8(O + off + bj * HALF, v0, v1); } }
    }
};
}

constexpr int NWAVES = 8;
typedef unsigned v2u __attribute__((ext_vector_type(2)));
constexpr size_t WS_WIN = 2 * MiB, WS_WC = 16 * MiB, WS_WO = 18 * MiB, WS_W1 = 20 * MiB, WS_W2 = 28 * MiB, WS_ROPET = 36 * MiB;
constexpr int CW_BAR = 4096;
constexpr size_t CTL_ZERO_BYTES = 1 * MiB;
constexpr int RING_OFF = 0, RING_BYTES = 131072;
constexpr int LDSCTL_OFF = RING_BYTES, MISC_OFF = LDSCTL_OFF + 320;
constexpr int LDS_BYTES = 147456;

struct Frame {
    LAS unsigned char* lds; volatile LAS unsigned* MISC;
    int tid, lane, wave, vcu, G;
};
__device__ __forceinline__ float wave_sum(float v) {
#pragma unroll
    for (int o = 1; o < 64; o <<= 1) v += __shfl_xor(v, o);
    return v;
}
__device__ __forceinline__ f32x4 bf4(unsigned lo, unsigned hi) { return (f32x4){__uint_as_float(lo << 16), __uint_as_float(lo & 0xffff0000u), __uint_as_float(hi << 16), __uint_as_float(hi & 0xffff0000u)}; }
__device__ __forceinline__ float gload_f32(const float* p) { return __uint_as_float(__hip_atomic_load((const unsigned*)p, __ATOMIC_RELAXED, __HIP_MEMORY_SCOPE_AGENT)); }

__device__ __forceinline__ int win_vrow(int n0) {
    if (n0 < 1024) return 256 * (n0 >> 7) + (n0 & 127);
    if (n0 < 2048) { const int n = n0 - 1024; return 256 * (n >> 7) + 128 + (n & 127); }
    if (n0 < 4096) { const int n = (n0 - 2048) & 1023, base = 2048 + ((n0 - 2048) & ~1023), head = n >> 6, half = (n >> 5) & 1; return base + 256 * (head >> 2) + 128 * half + 32 * (head & 3); }
    return n0;
}
template <bool PERMUTE> __device__ __forceinline__ void p0_transpose_item(const float* W, int K, int N, bf16* WT, LAS float* scr, int item, int lane) {
    const int nblk = N / 32, kb = item / nblk, nb = item % nblk, k0 = 64 * kb, n0 = 32 * nb;
    const int vr = PERMUTE ? win_vrow(n0) : n0;
#pragma unroll 8
    for (int i = 0; i < 32; ++i) { const int kk = 2 * i + (lane >> 5); scr[kk * 33 + (lane & 31)] = W[(size_t)(k0 + kk) * N + n0 + (lane & 31)]; }
    LDS_WAIT(); asm volatile("" ::: "memory");
    const int c = lane & 7;
#pragma unroll
    for (int j = 0; j < 4; ++j) { const int n = (lane >> 3) + 8 * j; const LAS float* s = scr + (8 * c) * 33 + n;
        v4u o; o.x = pk2(s[0 * 33], s[1 * 33]); o.y = pk2(s[2 * 33], s[3 * 33]); o.z = pk2(s[4 * 33], s[5 * 33]); o.w = pk2(s[6 * 33], s[7 * 33]);
        *(GAS v4u*)(WT + (size_t)(vr + n) * K + k0 + 8 * c) = o; }
    LDS_WAIT(); asm volatile("" ::: "memory");
}
__device__ __forceinline__ void sincos_d(double a, float& s, float& c) {
    const double k = __builtin_rint(a * 0.6366197723675814);
    double y = __builtin_fma(-k, 1.5707963267948966, a); y = __builtin_fma(-k, 6.123233995736766e-17, y);
    const double y2 = y * y;
    double sp = 1.0 / 6227020800.0; sp = sp * y2 - 1.0 / 39916800.0; sp = sp * y2 + 1.0 / 362880.0; sp = sp * y2 - 1.0 / 5040.0; sp = sp * y2 + 1.0 / 120.0; sp = sp * y2 - 1.0 / 6.0; sp = sp * y2 * y + y;
    double cp = 1.0 / 479001600.0; cp = cp * y2 - 1.0 / 3628800.0; cp = cp * y2 + 1.0 / 40320.0; cp = cp * y2 - 1.0 / 720.0; cp = cp * y2 + 1.0 / 24.0; cp = cp * y2 - 0.5; cp = cp * y2 + 1.0;
    const int q = ((int)k) & 3;
    const double sv = (q & 1) ? cp : sp, cv = (q & 1) ? sp : cp;
    s = (float)((q & 2) ? -sv : sv); c = (float)(((q + 1) & 2) ? -cv : cv);
}

struct Ptrs {
    const float *x, *c, *w_ada, *b_ada, *pre1, *post1, *w_in, *conv_w, *conv_b, *ln_g, *ln_b, *wc_out, *bc_out, *lq1, *lk1, *lq2, *lk2, *hn, *w_o, *pre2, *post2, *w1, *w2;
    float *out, *mod, *rope;
    bf16 *WIN, *WC, *WO, *W1, *W2, *R[7];
};

__device__ __forceinline__ void p0_prologue(Frame& F, const Ptrs& P) {
    {
        LAS float* red = (LAS float*)(F.lds + RING_OFF);
        const int j = F.tid & 31, kg = F.tid >> 5;
        for (int cb = F.vcu; cb < 256; cb += F.G) {
            const int col = cb * 24 + j; float a0 = 0.f, a1 = 0.f, a2 = 0.f, a3 = 0.f;
            if (j < 24) for (int k = kg * 64; k < kg * 64 + 64; ++k) { const float w = P.w_ada[(size_t)k * 6144 + col];
                const float c0 = P.c[k], c1 = P.c[1024 + k], c2 = P.c[2048 + k], c3 = P.c[3072 + k];
                a0 += c0 * sigmoidf_(c0) * w; a1 += c1 * sigmoidf_(c1) * w; a2 += c2 * sigmoidf_(c2) * w; a3 += c3 * sigmoidf_(c3) * w; }
            red[(kg * 4 + 0) * 32 + j] = a0; red[(kg * 4 + 1) * 32 + j] = a1; red[(kg * 4 + 2) * 32 + j] = a2; red[(kg * 4 + 3) * 32 + j] = a3;
            __syncthreads();
            if (F.tid < 128 && j < 24) { const int b = F.tid >> 5; float s = 0.f;
#pragma unroll
                for (int g = 0; g < 16; ++g) s += red[(g * 4 + b) * 32 + j];
                P.mod[b * 6144 + col] = s + P.b_ada[col]; }
            __syncthreads();
        }
        if (blockIdx.x == 0 && F.tid == 0) { float s1 = 0.f, s2 = 0.f;
            for (int i = 0; i < 64; ++i) { s1 += P.lq1[i] * P.lk1[i]; s2 += P.lq2[i] * P.lk2[i]; }
            P.mod[4 * 6144] = __expf(s1) - __expf(s2) + LAM_INIT; }
    }
    {
        const int gt = F.vcu * (NWAVES * 64) + F.tid, NT_ = F.G * NWAVES * 64;
        for (int e = gt; e < T * 32; e += NT_) { const int t = e >> 5, d = e & 31; double invf = 1.0;
            for (int i = 0; i < d; ++i) invf *= 0.7498942093324559;
            float s, c; sincos_d((double)t * invf, s, c); *(float2*)(P.rope + 2 * (size_t)e) = make_float2(c, s); }
    }
    {
        LAS float* scr = (LAS float*)(F.lds + RING_OFF + F.wave * 16384);
        const int gw = F.vcu * NWAVES + F.wave, NGW = F.G * NWAVES;
        constexpr int I_IN = (D / 64) * (DIN / 32), I_C = (D / 64) * (D / 32), I_O = I_C, I_1 = (D / 64) * (FF / 32), I_2 = (FF / 64) * (D / 32);
        constexpr int NITEMS = I_IN + I_C + I_O + I_1 + I_2;
        for (int it = gw; it < NITEMS; it += NGW) {
            int r = it;
            if (r < I_IN) { p0_transpose_item<true>(P.w_in, D, DIN, P.WIN, scr, r, F.lane); continue; } r -= I_IN;
            if (r < I_C) { p0_transpose_item<false>(P.wc_out, D, D, P.WC, scr, r, F.lane); continue; } r -= I_C;
            if (r < I_O) { p0_transpose_item<false>(P.w_o, D, D, P.WO, scr, r, F.lane); continue; } r -= I_O;
            if (r < I_1) { p0_transpose_item<false>(P.w1, D, FF, P.W1, scr, r, F.lane); continue; } r -= I_1;
            p0_transpose_item<false>(P.w2, FF, D, P.W2, scr, r, F.lane);
        }
    }
}
__device__ __forceinline__ void p1_h1(Frame& F, const Ptrs& P, bf16* XN) {
    const int gw = F.vcu * NWAVES + F.wave, NGW = F.G * NWAVES;
    for (int b = 0; b < BATCH; ++b) {
        const float* mb = P.mod + b * 6144; f32x4 A[4], Bv[4];
#pragma unroll
        for (int j = 0; j < 4; ++j) { const int c = 4 * F.lane + 256 * j; A[j] = *(const f32x4*)(P.pre1 + c) * (*(const f32x4*)(mb + 1024 + c) + 1.0f); Bv[j] = *(const f32x4*)(mb + c); }
        for (int r = gw; r < T; r += NGW) { const size_t row = (size_t)b * T + r;
            const GAS f32x4* xr = (const GAS f32x4*)(P.x + row * D) + F.lane; f32x4 v[4]; float s = 0.f;
#pragma unroll
            for (int j = 0; j < 4; ++j) { v[j] = xr[64 * j]; s += (v[j].x * v[j].x + v[j].y * v[j].y) + (v[j].z * v[j].z + v[j].w * v[j].w); }
            const float rstd = rsqrtf(wave_sum(s) * (1.f / D) + EPS);
            GAS unsigned long long* o8 = (GAS unsigned long long*)(XN + row * D) + F.lane;
#pragma unroll
            for (int j = 0; j < 4; ++j) { const f32x4 o = v[j] * rstd * A[j] + Bv[j]; o8[64 * j] = (unsigned long long)pk2(o.x, o.y) | ((unsigned long long)pk2(o.z, o.w) << 32); } }
    }
}
__device__ __forceinline__ void p3_conv(Frame& F, const Ptrs& P, const bf16* U, bf16* UC) {
    LAS unsigned char* lds = F.lds + RING_OFF;
    LAS float* P1 = (LAS float*)(lds + 62 * 2048); LAS float* P2 = P1 + 128;
    const int cq = F.wave & 3, th = F.wave >> 2, ch0 = cq * 256 + 4 * F.lane;
    const f32x4 cb = *(const f32x4*)(P.conv_b + ch0);
    for (int tile = F.vcu; tile < M / 32; tile += F.G) {
        const int row0 = tile * 32, t0 = row0 & (T - 1);
        for (int i = F.tid; i < 62 * 128; i += NWAVES * 64) { const int r = i >> 7, c16 = i & 127; v4u val = {0u, 0u, 0u, 0u};
            if (t0 - 30 + r >= 0) val = *(const GAS v4u*)(U + (size_t)(row0 - 30 + r) * D + c16 * 8);
            *(LAS v4u*)(lds + r * 2048 + c16 * 16) = val; }
        __syncthreads();
        f32x4 acc[16];
#pragma unroll
        for (int k = 0; k < 16; ++k) acc[k] = cb;
#pragma unroll 1
        for (int tb = 0; tb < 4; ++tb) {
            f32x4 w[8];
#pragma unroll
            for (int i = 0; i < 8; ++i) { const int tap = 8 * tb + i; w[i] = *(const f32x4*)(P.conv_w + (size_t)(tap < CWID ? tap : 0) * D + ch0); if (tap >= CWID) w[i] = (f32x4){0.f, 0.f, 0.f, 0.f}; }
            const LAS unsigned char* base = lds + (th * 16 + 8 * tb) * 2048 + ch0 * 2;
#pragma unroll
            for (int r = 0; r < 23; ++r) { v2u raw = *(const LAS v2u*)(base + r * 2048); if (r == 22 && tb == 3) raw = (v2u){0u, 0u};
                const f32x4 u = bf4(raw.x, raw.y);
#pragma unroll
                for (int k = 0; k < 16; ++k) { const int tl = r - k; if (tl >= 0 && tl < 8) acc[k] += u * w[tl]; } }
        }
#pragma unroll
        for (int k = 0; k < 16; ++k) { const float s = wave_sum((acc[k].x + acc[k].y) + (acc[k].z + acc[k].w)); if (F.lane == 0) P1[(th * 16 + k) * 4 + cq] = s; }
        __syncthreads();
#pragma unroll
        for (int k = 0; k < 16; ++k) { const f32x4 p = *(const LAS f32x4*)(P1 + (th * 16 + k) * 4); const float mean = ((p.x + p.y) + (p.z + p.w)) * (1.f / D);
            acc[k] = acc[k] - mean; const f32x4 a = acc[k]; const float q = wave_sum((a.x * a.x + a.y * a.y) + (a.z * a.z + a.w * a.w)); if (F.lane == 0) P2[(th * 16 + k) * 4 + cq] = q; }
        __syncthreads();
        const f32x4 lg = *(const f32x4*)(P.ln_g + ch0), lb = *(const f32x4*)(P.ln_b + ch0);
#pragma unroll
        for (int k = 0; k < 16; ++k) { const f32x4 p = *(const LAS f32x4*)(P2 + (th * 16 + k) * 4); const float rstd = rsqrtf(((p.x + p.y) + (p.z + p.w)) * (1.f / D) + EPS);
            f32x4 y = acc[k] * rstd * lg + lb;
#pragma unroll
            for (int i = 0; i < 4; ++i) y[i] = y[i] * pg8::fast_sigmoid(y[i]);
            *(GAS unsigned long long*)(UC + (size_t)(row0 + th * 16 + k) * D + ch0) = (unsigned long long)pk2(y.x, y.y) | ((unsigned long long)pk2(y.z, y.w) << 32); }
    }
    __syncthreads();
}
__device__ __forceinline__ void p6_combine(Frame& F, const Ptrs& P, const bf16* O1, const bf16* O2, const bf16* YC, const bf16* GA, bf16* Z) {
    const int gw = F.vcu * NWAVES + F.wave, NGW = F.G * NWAVES;
    const float lam = gload_f32(P.mod + 4 * 6144); const f32x4 hn4 = *(const f32x4*)(P.hn + 4 * (F.lane & 31)) * (1.f - LAM_INIT);
    for (int row = gw; row < M; row += NGW) { const size_t off = (size_t)row * D + 4 * F.lane;
#pragma unroll
        for (int j = 0; j < 4; ++j) { const v2u r1 = *(const GAS v2u*)(O1 + off + 256 * j), r2 = *(const GAS v2u*)(O2 + off + 256 * j), ry = *(const GAS v2u*)(YC + off + 256 * j), rg = *(const GAS v2u*)(GA + off + 256 * j);
            const f32x4 a = bf4(r1.x, r1.y) - bf4(r2.x, r2.y) * lam; float ss = (a.x * a.x + a.y * a.y) + (a.z * a.z + a.w * a.w);
#pragma unroll
            for (int o = 1; o < 32; o <<= 1) ss += __shfl_xor(ss, o);
            const float rstd = rsqrtf(ss * (1.f / VD) + EPS);
            const f32x4 z = bf4(ry.x, ry.y) + bf4(rg.x, rg.y) * (a * rstd * hn4);
            *(GAS unsigned long long*)(Z + off + 256 * j) = (unsigned long long)pk2(z.x, z.y) | ((unsigned long long)pk2(z.z, z.w) << 32); } }
}
__device__ __forceinline__ void p8_x1(Frame& F, const Ptrs& P, const bf16* Y, bf16* XN) {
    const int gw = F.vcu * NWAVES + F.wave, NGW = F.G * NWAVES;
    for (int b = 0; b < BATCH; ++b) {
        const float* mb = P.mod + b * 6144; f32x4 G1[4], A2[4], B2[4];
#pragma unroll
        for (int j = 0; j < 4; ++j) { const int c = 4 * F.lane + 256 * j; G1[j] = *(const f32x4*)(mb + 2048 + c) * *(const f32x4*)(P.post1 + c);
            A2[j] = *(const f32x4*)(P.pre2 + c) * (*(const f32x4*)(mb + 4096 + c) + 1.0f); B2[j] = *(const f32x4*)(mb + 3072 + c); }
        for (int r = gw; r < T; r += NGW) { const size_t row = (size_t)b * T + r, off = row * D + 4 * F.lane;
            f32x4 y[4], xv[4]; float s = 0.f;
#pragma unroll
            for (int j = 0; j < 4; ++j) { const v2u ry = *(const GAS v2u*)(Y + off + 256 * j); y[j] = bf4(ry.x, ry.y); xv[j] = *(const GAS f32x4*)(P.x + off + 256 * j);
                s += (y[j].x * y[j].x + y[j].y * y[j].y) + (y[j].z * y[j].z + y[j].w * y[j].w); }
            const float rstd = rsqrtf(wave_sum(s) * (1.f / D) + EPS); float s2 = 0.f;
#pragma unroll
            for (int j = 0; j < 4; ++j) { xv[j] = xv[j] + G1[j] * (y[j] * rstd); *(GAS f32x4*)(P.out + off + 256 * j) = xv[j];
                s2 += (xv[j].x * xv[j].x + xv[j].y * xv[j].y) + (xv[j].z * xv[j].z + xv[j].w * xv[j].w); }
            const float rstd2 = rsqrtf(wave_sum(s2) * (1.f / D) + EPS);
#pragma unroll
            for (int j = 0; j < 4; ++j) { const f32x4 o = xv[j] * rstd2 * A2[j] + B2[j];
                *(GAS unsigned long long*)(XN + off + 256 * j) = (unsigned long long)pk2(o.x, o.y) | ((unsigned long long)pk2(o.z, o.w) << 32); } }
    }
}
__device__ __forceinline__ void p11_out(Frame& F, const Ptrs& P, const bf16* Fb) {
    const int gw = F.vcu * NWAVES + F.wave, NGW = F.G * NWAVES;
    for (int b = 0; b < BATCH; ++b) {
        const float* mb = P.mod + b * 6144; f32x4 G2[4];
#pragma unroll
        for (int j = 0; j < 4; ++j) { const int c = 4 * F.lane + 256 * j; G2[j] = *(const f32x4*)(mb + 5120 + c) * *(const f32x4*)(P.post2 + c); }
        for (int r = gw; r < T; r += NGW) { const size_t row = (size_t)b * T + r, off = row * D + 4 * F.lane;
            f32x4 y[4], xv[4]; float s = 0.f;
#pragma unroll
            for (int j = 0; j < 4; ++j) { const v2u ry = *(const GAS v2u*)(Fb + off + 256 * j); y[j] = bf4(ry.x, ry.y); xv[j] = *(const GAS f32x4*)(P.out + off + 256 * j);
                s += (y[j].x * y[j].x + y[j].y * y[j].y) + (y[j].z * y[j].z + y[j].w * y[j].w); }
            const float rstd = rsqrtf(wave_sum(s) * (1.f / D) + EPS);
#pragma unroll
            for (int j = 0; j < 4; ++j) *(GAS f32x4*)(P.out + off + 256 * j) = xv[j] + G2[j] * (y[j] * rstd); }
    }
}

struct Args { const float* in[23]; float* out; unsigned char* ws; int ph_lo, ph_hi, li, pad; };
typedef const Args __attribute__((address_space(4))) CArgs;
__device__ __forceinline__ CArgs* kargs() { CArgs* p = (CArgs*)__builtin_amdgcn_kernarg_segment_ptr(); asm volatile("" : "+s"(p)); return p; }
__device__ __forceinline__ Ptrs make_ptrs(CArgs* A) {
    Ptrs P; unsigned char* ws = A->ws;
    P.x = A->in[0]; P.c = A->in[1]; P.w_ada = A->in[2]; P.b_ada = A->in[3]; P.pre1 = A->in[4]; P.post1 = A->in[5]; P.w_in = A->in[6]; P.conv_w = A->in[7];
    P.conv_b = A->in[8]; P.ln_g = A->in[9]; P.ln_b = A->in[10]; P.wc_out = A->in[11]; P.bc_out = A->in[12]; P.lq1 = A->in[13]; P.lk1 = A->in[14]; P.lq2 = A->in[15];
    P.lk2 = A->in[16]; P.hn = A->in[17]; P.w_o = A->in[18]; P.pre2 = A->in[19]; P.post2 = A->in[20]; P.w1 = A->in[21]; P.w2 = A->in[22];
    P.out = A->out; P.mod = (float*)(ws + WS_MOD); P.rope = (float*)(ws + WS_ROPET);
    P.WIN = (bf16*)(ws + WS_WIN); P.WC = (bf16*)(ws + WS_WC); P.WO = (bf16*)(ws + WS_WO); P.W1 = (bf16*)(ws + WS_W1); P.W2 = (bf16*)(ws + WS_W2);
#pragma unroll
    for (int i = 0; i < 7; ++i) P.R[i] = (bf16*)(ws + WS_R0 + (size_t)i * RSZ);
    return P;
}
#define PHASE_BEGIN() const Ptrs P = make_ptrs(kargs()); { int t_ = threadIdx.x; asm volatile("" : "+v"(t_)); F.tid = t_; F.lane = t_ & 63; } \
    bf16 *XN = P.R[0], *U = P.R[1], *Q = P.R[2], *Kb = P.R[3], *V = P.R[4], *GC = P.R[5], *GA = P.R[6]; \
    bf16 *UC = P.R[0], *YC = P.R[1], *O1 = P.R[0], *O2 = P.R[5], *Z = P.R[2], *Y = P.R[3], *F1 = P.R[1], *Fb = P.R[5]; \
    (void)XN; (void)U; (void)Q; (void)Kb; (void)V; (void)GC; (void)GA; (void)UC; (void)YC; (void)O1; (void)O2; (void)Z; (void)Y; (void)F1; (void)Fb;
__global__ void __launch_bounds__(NWAVES * 64, 2) mega_fwd(Args args) {
    extern __shared__ __attribute__((aligned(16))) unsigned char lds[];
    Frame F;
    F.lds = (LAS unsigned char*)lds;
    F.MISC = (volatile LAS unsigned*)(F.lds + MISC_OFF);
    F.tid = threadIdx.x; F.lane = F.tid & 63; F.wave = __builtin_amdgcn_readfirstlane(F.tid >> 6);
    F.G = gridDim.x; { const int bx = blockIdx.x; F.vcu = (F.G % 8 == 0) ? (bx % 8) * (F.G / 8) + bx / 8 : bx; }
    unsigned char* ws = args.ws;
    for (int u = F.tid; u < (LDS_BYTES - LDSCTL_OFF) / 4; u += NWAVES * 64) ((LAS unsigned*)(F.lds + LDSCTL_OFF))[u] = 0u;
    __syncthreads();
    XcdBarrier bar = xcd_barrier_post((unsigned*)(ws + WS_CTL) + CW_BAR + args.li * XCD_BAR_WORDS, F.MISC + 8);
    const int lo = args.ph_lo, hi = args.ph_hi;
#ifndef PHMASK
#define PHMASK 0xFFF
#endif
#define IN(k) ((((PHMASK) >> (k)) & 1) && lo <= (k) && (k) < hi)
#define SEAM(k) do { if (IN(k) && IN((k) + 1)) xcd_barrier(bar); } while (0)
#ifndef DOUBLE_MASK
#define DOUBLE_MASK 0x000
#endif
#define REPS(k) _Pragma("unroll 1") for (int rep_ = 0; rep_ < ((((DOUBLE_MASK) >> (k)) & 1) ? 2 : 1); ++rep_)
    if (IN(0)) { PHASE_BEGIN(); p0_prologue(F, P); SEAM(0); }
    if (IN(1)) { PHASE_BEGIN(); REPS(1) p1_h1(F, P, XN); SEAM(1); }
    if (IN(2)) { PHASE_BEGIN();
        pg8::Gemm g{XN, P.WIN, M, DIN, D}; pg8::StaticOrder S; S.init(M, DIN, F.G, (int)blockIdx.x);
        pg8::EpiProj E{U, Q, Kb, V, GC, GA, P.rope};
        REPS(2) pg8::gemm_phase<pg8::EpiProj, pg8::StaticOrder, PG8_ALIGN, PG8_SP2>(F.lds + RING_OFF, g, S, E);
        SEAM(2); }
    if (IN(3)) { PHASE_BEGIN(); REPS(3) p3_conv(F, P, U, UC); SEAM(3); }
    if (IN(4)) { PHASE_BEGIN();
        pg8::Gemm g{UC, P.WC, M, D, D}; pg8::StaticOrder S; S.init(M, D, F.G, (int)blockIdx.x);
        pg8::EpiPlain<1> E{YC, D, P.bc_out, GC};
        pg8::gemm_phase<pg8::EpiPlain<1>, pg8::StaticOrder, PG8_ALIGN, PG8_SP2>(F.lds + RING_OFF, g, S, E);
        SEAM(4); }
    if (IN(5)) { PHASE_BEGIN();
        const attn2::AttnTensors AT{(const attn2::bf16*)Q, (const attn2::bf16*)Kb, (const attn2::bf16*)V, (attn2::bf16*)O1, (attn2::bf16*)O2};
        const attn2::DealOrder S(F.vcu);
        if (F.G == 256) attn2::attn_phase<attn2::DealOrder>((char*)lds + RING_OFF, AT, S);
        SEAM(5); }
    if (IN(6)) { PHASE_BEGIN(); REPS(6) p6_combine(F, P, O1, O2, YC, GA, Z); SEAM(6); }
    if (IN(7)) { PHASE_BEGIN();
        pg8::Gemm g{Z, P.WO, M, D, D}; pg8::StaticOrder S; S.init(M, D, F.G, (int)blockIdx.x);
        pg8::EpiPlain<0> E{Y, D, nullptr, nullptr};
        pg8::gemm_phase<pg8::EpiPlain<0>, pg8::StaticOrder, PG8_ALIGN, PG8_SP2>(F.lds + RING_OFF, g, S, E);
        SEAM(7); }
    if (IN(8)) { PHASE_BEGIN(); REPS(8) p8_x1(F, P, Y, XN); SEAM(8); }
    if (IN(9)) { PHASE_BEGIN();
        pg8::Gemm g{XN, P.W1, M, FF, D}; pg8::StaticOrder S; S.init(M, FF, F.G, (int)blockIdx.x);
        pg8::EpiPlain<2> E{F1, FF, nullptr, nullptr};
        pg8::gemm_phase<pg8::EpiPlain<2>, pg8::StaticOrder, PG8_ALIGN, PG8_SP2>(F.lds + RING_OFF, g, S, E);
        SEAM(9); }
    if (IN(10)) { PHASE_BEGIN();
        pg8::Gemm g{F1, P.W2, M, D, FF}; pg8::StaticOrder S; S.init(M, D, F.G, (int)blockIdx.x);
        pg8::EpiPlain<0> E{Fb, D, nullptr, nullptr};
        pg8::gemm_phase<pg8::EpiPlain<0>, pg8::StaticOrder, PG8_ALIGN, PG8_SP2>(F.lds + RING_OFF, g, S, E);
        SEAM(10); }
    if (IN(11)) { PHASE_BEGIN(); p11_out(F, P, Fb); }
#undef IN
#undef SEAM
}

#ifndef FASTMASK
#define PATCH_YN 16
#define FASTMASK 0xFFF
#endif
extern "C" void kernel_launch(void* const* d_in, const int* in_sizes, int n_in, void* d_out, int out_size, void* d_ws, size_t ws_size, hipStream_t stream) {
    static int grid = 0;
    if (grid == 0) {
        if (n_in != 23 || in_sizes[0] != M * D || out_size != M * D || ws_size < WS_END) { fprintf(stderr, "kernel_launch: unexpected shapes (n_in %d in0 %d out %d ws %zu)\n", n_in, n_in > 0 ? in_sizes[0] : -1, out_size, ws_size); grid = -1; return; }
        int dev = 0, cus = 0;
        if (hipGetDevice(&dev) != hipSuccess || hipDeviceGetAttribute(&cus, hipDeviceAttributeMultiprocessorCount, dev) != hipSuccess) { fprintf(stderr, "kernel_launch: device query failed\n"); grid = -1; return; }
        if (hipFuncSetAttribute((const void*)mega_fwd, hipFuncAttributeMaxDynamicSharedMemorySize, LDS_BYTES) != hipSuccess) { fprintf(stderr, "kernel_launch: hipFuncSetAttribute failed\n"); grid = -1; return; }
        (void)hipGetLastError();
        grid = cus;
        if (grid != 256) fprintf(stderr, "kernel_launch: %d CUs; the attention phase is dealt for 256\n", grid);
    }
    if (grid < 0) return;
    const float* x = (const float*)d_in[0]; const float* c = (const float*)d_in[1]; const float* w_ada = (const float*)d_in[2]; const float* b_ada = (const float*)d_in[3];
    const float* pre1 = (const float*)d_in[4]; const float* post1 = (const float*)d_in[5]; const float* w_in = (const float*)d_in[6]; const float* conv_w = (const float*)d_in[7];
    const float* conv_b = (const float*)d_in[8]; const float* ln_g = (const float*)d_in[9]; const float* ln_b = (const float*)d_in[10]; const float* wc_out = (const float*)d_in[11];
    const float* bc_out = (const float*)d_in[12]; const float* lq1 = (const float*)d_in[13]; const float* lk1 = (const float*)d_in[14]; const float* lq2 = (const float*)d_in[15];
    const float* lk2 = (const float*)d_in[16]; const float* hn = (const float*)d_in[17]; const float* w_o = (const float*)d_in[18]; const float* pre2 = (const float*)d_in[19];
    const float* post2 = (const float*)d_in[20]; const float* w1 = (const float*)d_in[21]; const float* w2 = (const float*)d_in[22];
    float* out = (float*)d_out; unsigned char* ws = (unsigned char*)d_ws;
    float* mod = (float*)(ws + WS_MOD);
    bf16* R[7]; for (int i = 0; i < 7; ++i) R[i] = (bf16*)(ws + WS_R0 + i * RSZ);
    bf16 *XN = R[0], *U = R[1], *Q = R[2], *Kb = R[3], *V = R[4], *GC = R[5], *GA = R[6];
    bf16 *UC = R[0], *YC = R[1], *O1 = R[0], *O2 = R[5], *Z = R[2], *Y = R[3], *F1 = R[1], *F = R[5];
    (void)hipMemsetAsync(ws + WS_CTL, 0, CTL_ZERO_BYTES, stream);
    Args a{};
    for (int i = 0; i < 23; ++i) a.in[i] = (const float*)d_in[i];
    a.out = out; a.ws = ws;
    int li = 0;
    auto mega = [&](int lo, int hi) { a.ph_lo = lo; a.ph_hi = hi; a.li = li++; hipLaunchKernelGGL(mega_fwd, dim3(grid), dim3(NWAVES * 64), LDS_BYTES, stream, a);
        const hipError_t le = hipPeekAtLastError(); if (le != hipSuccess) fprintf(stderr, "kernel_launch: launch [%d,%d) failed: %s\n", lo, hi, hipGetErrorName(le)); };
    const unsigned mask = FASTMASK;
#ifndef SPLIT_LAUNCHES
#define SPLIT_LAUNCHES 0
#endif
    if (mask == 0xFFFu && !SPLIT_LAUNCHES) { mega(0, 12); return; }
    if (mask == 0xFFFu) { for (int s = 0; s < 12; ++s) mega(s, s + 1); return; }
    auto naive = [&](int s) {
        switch (s) {
        case 0: nv_mod<<<dim3(6144 / 256, BATCH), 256, 0, stream>>>(c, w_ada, b_ada, lq1, lk1, lq2, lk2, mod); break;
        case 1: nv_h1<<<M, 256, 0, stream>>>(x, mod, pre1, XN); break;
        case 2: nv_gemm<NvProj><<<dim3(M / 64, 3584 / 64), 256, 0, stream>>>(XN, D, w_in, DIN, NvProj{U, Q, Kb, V, GC, GA}); break;
        case 3: nv_conv<<<M, 256, 0, stream>>>(U, conv_w, conv_b, ln_g, ln_b, UC); break;
        case 4: nv_gemm<NvPlain<1>><<<dim3(M / 64, 512 / 64), 256, 0, stream>>>(UC, D, wc_out, D, NvPlain<1>{YC, D, 512, bc_out, GC}); break;
        case 5: nv_attn<<<dim3(T / 128, 32, BATCH), 128, 0, stream>>>(Q, Kb, V, O1, O2); break;
        case 6: nv_combine<<<M, 256, 0, stream>>>(O1, O2, YC, GA, hn, mod, Z); break;
        case 7: nv_gemm<NvPlain<0>><<<dim3(M / 64, 512 / 64), 256, 0, stream>>>(Z, D, w_o, D, NvPlain<0>{Y, D, 512, nullptr, nullptr}); break;
        case 8: nv_x1<<<M, 256, 0, stream>>>(x, Y, mod, post1, pre2, out, XN); break;
        case 9: nv_gemm<NvPlain<2>><<<dim3(M / 64, 2048 / 64), 256, 0, stream>>>(XN, D, w1, FF, NvPlain<2>{F1, FF, 2048, nullptr, nullptr}); break;
        case 10: nv_gemm<NvPlain<0>><<<dim3(M / 64, 512 / 64), 256, 0, stream>>>(F1, FF, w2, D, NvPlain<0>{F, D, 512, nullptr, nullptr}); break;
        default: nv_out<<<M, 256, 0, stream>>>(F, mod, post2, out); break;
        } };
    const bool need_w = (mask & ((1u << 2) | (1u << 4) | (1u << 7) | (1u << 9) | (1u << 10))) != 0;
    int s = 0;
    if (!(mask & 1u)) { if (need_w) mega(0, 1); naive(0); s = 1; }
    while (s < 12) {
        if ((mask >> s) & 1u) { int e = s; while (e < 12 && ((mask >> e) & 1u)) ++e; mega(s, e);
#ifdef PATCH_Y0
            if (s <= 2 && e > 2) nv_gemm<NvProj><<<dim3(M / 64, PATCH_YN), 256, 0, stream>>>(XN, D, w_in, DIN, NvProj{U, Q, Kb, V, GC, GA}, PATCH_Y0);
#endif
            s = e; }
        else { naive(s); ++s; }
    }
}
```

```cpp
#include <hip/hip_runtime.h>
#include <cstdio>
#include <cstdint>
#include <cmath>

constexpr int BATCH = 4, T = 8192, D = 1024, M = BATCH * T, DIN = 7168, FF = 4096, NH = 8, HD = 64, VD = 128, CWID = 31;
constexpr float EPS = 1e-6f, LAM_INIT = 0.2f;
constexpr float C2 = 0.18033688011112042f;

typedef unsigned short bf16;
__device__ __forceinline__ float bf2f(bf16 v) { return __uint_as_float(((unsigned)v) << 16); }
__device__ __forceinline__ unsigned f2bf(float f) { unsigned u = __float_as_uint(f); return (u + 0x7fffu + ((u >> 16) & 1u)) >> 16; }
__device__ __forceinline__ unsigned pk2(float lo, float hi) { return f2bf(lo) | (f2bf(hi) << 16); }
__device__ __forceinline__ float sigmoidf_(float v) { return 1.f / (1.f + __expf(-v)); }

constexpr size_t MiB = 1u << 20;
constexpr size_t WS_CTL = 0;
constexpr size_t WS_MOD = 1 * MiB;
constexpr size_t WS_ROPE = 1 * MiB + 512 * 1024;
constexpr size_t WS_R0 = 40 * MiB;
constexpr size_t RSZ = 64 * MiB;
constexpr size_t WS_END = WS_R0 + 7 * RSZ;

__device__ __forceinline__ float block_sum256(float v, float* red) {
#pragma unroll
    for (int o = 1; o < 64; o <<= 1) v += __shfl_xor(v, o);
    __syncthreads();
    if ((threadIdx.x & 63) == 0) red[threadIdx.x >> 6] = v;
    __syncthreads();
    return (red[0] + red[1]) + (red[2] + red[3]);
}

__global__ void __launch_bounds__(256) nv_mod(const float* c, const float* w_ada, const float* b_ada, const float* lq1, const float* lk1, const float* lq2, const float* lk2, float* mod) {
    const int col = blockIdx.x * 256 + threadIdx.x, b = blockIdx.y;
    float acc = 0.f;
    for (int k = 0; k < D; ++k) { const float cv = c[b * D + k]; acc += (cv * sigmoidf_(cv)) * w_ada[(size_t)k * 6144 + col]; }
    mod[b * 6144 + col] = acc + b_ada[col];
    if (blockIdx.x == 0 && blockIdx.y == 0 && threadIdx.x == 0) {
        float s1 = 0.f, s2 = 0.f;
        for (int i = 0; i < 64; ++i) { s1 += lq1[i] * lk1[i]; s2 += lq2[i] * lk2[i]; }
        mod[4 * 6144] = __expf(s1) - __expf(s2) + LAM_INIT;
    }
}

__global__ void __launch_bounds__(256) nv_h1(const float* x, const float* mod, const float* g, bf16* XN) {
    __shared__ float red[4];
    const int row = blockIdx.x, b = row / T, tid = threadIdx.x, c0 = tid * 4;
    const float4 v = ((const float4*)(x + (size_t)row * D))[tid];
    const float ss = block_sum256(v.x * v.x + v.y * v.y + v.z * v.z + v.w * v.w, red);
    const float rstd = rsqrtf(ss * (1.f / D) + EPS);
    const float* sh = mod + b * 6144; const float* sc = sh + 1024;
    const float vv[4] = {v.x, v.y, v.z, v.w}; float o[4];
#pragma unroll
    for (int j = 0; j < 4; ++j) o[j] = vv[j] * rstd * g[c0 + j] * (1.f + sc[c0 + j]) + sh[c0 + j];
    uint2 w; w.x = pk2(o[0], o[1]); w.y = pk2(o[2], o[3]);
    *(uint2*)(XN + (size_t)row * D + c0) = w;
}

template <class E> __global__ void __launch_bounds__(256) nv_gemm(const bf16* A, int K, const float* W, int ldw, E e, int yoff = 0) {
    __shared__ float As[64][36];
    const int tid = threadIdx.x, ix = tid & 63, iy = tid >> 6;
    const int row0 = blockIdx.x * 64, item = (blockIdx.y + yoff) * 64 + ix;
    int c0, c1; e.cols(item, c0, c1);
    float acc0[16], acc1[16];
#pragma unroll
    for (int r = 0; r < 16; ++r) { acc0[r] = 0.f; acc1[r] = 0.f; }
    for (int k0 = 0; k0 < K; k0 += 32) {
        { const int r = tid >> 2, kc = (tid & 3) * 8;
          const uint4 raw = *(const uint4*)(A + (size_t)(row0 + r) * K + k0 + kc);
          const unsigned w[4] = {raw.x, raw.y, raw.z, raw.w};
#pragma unroll
          for (int j = 0; j < 4; ++j) { As[r][kc + 2 * j] = __uint_as_float(w[j] << 16); As[r][kc + 2 * j + 1] = __uint_as_float(w[j] & 0xffff0000u); } }
        __syncthreads();
#pragma unroll 2
        for (int kk = 0; kk < 32; kk += 4) {
            float w0[4], w1[4];
#pragma unroll
            for (int j = 0; j < 4; ++j) { w0[j] = W[(size_t)(k0 + kk + j) * ldw + c0]; w1[j] = W[(size_t)(k0 + kk + j) * ldw + c1]; }
#pragma unroll
            for (int r = 0; r < 16; ++r) { const float4 a = *(const float4*)&As[iy * 16 + r][kk];
                acc0[r] += a.x * w0[0] + a.y * w0[1] + a.z * w0[2] + a.w * w0[3];
                acc1[r] += a.x * w1[0] + a.y * w1[1] + a.z * w1[2] + a.w * w1[3]; }
        }
        __syncthreads();
    }
#pragma unroll
    for (int r = 0; r < 16; ++r) e.store(row0 + iy * 16 + r, item, acc0[r], acc1[r]);
}

struct NvProj {
    bf16 *U, *Q, *Kb, *V, *GC, *GA;
    __device__ void cols(int item, int& c0, int& c1) const {
        if (item < 1024) { c0 = item; c1 = 1024 + item; }
        else if (item < 2048) { const int i = item - 1024, qk = i >> 9, j = i & 511, mh = j >> 5, d = j & 31; c0 = 2048 + qk * 1024 + mh * 64 + d; c1 = c0 + 32; }
        else if (item < 2560) { const int i = item - 2048; c0 = 4096 + i; c1 = 4096 + 512 + i; }
        else { const int i = item - 2560; c0 = 5120 + i; c1 = 6144 + i; }
    }
    __device__ void store(int row, int item, float a0, float a1) const {
        if (item < 1024) { U[(size_t)row * D + item] = (bf16)f2bf(a0 * sigmoidf_(a1)); }
        else if (item < 2048) { const int i = item - 1024, qk = i >> 9, j = i & 511, mh = j >> 5, d = j & 31; const int t = row % T;
            const float invf = powf(10000.f, -(float)d / 32.f), ang = (float)t * invf; const float cs = cosf(ang), sn = sinf(ang);
            float o1 = a0 * cs - a1 * sn, o2 = a1 * cs + a0 * sn; bf16* P = qk ? Kb : Q; if (!qk) { o1 *= C2; o2 *= C2; }
            P[(size_t)row * D + mh * 64 + d] = (bf16)f2bf(o1); P[(size_t)row * D + mh * 64 + 32 + d] = (bf16)f2bf(o2); }
        else if (item < 2560) { const int i = item - 2048; V[(size_t)row * D + i] = (bf16)f2bf(a0); V[(size_t)row * D + 512 + i] = (bf16)f2bf(a1); }
        else { const int i = item - 2560; GC[(size_t)row * D + i] = (bf16)f2bf(sigmoidf_(a0)); GA[(size_t)row * D + i] = (bf16)f2bf(sigmoidf_(a1)); }
    }
};
template <int MODE> struct NvPlain {
    bf16* O; int ldo, nhalf; const float* bias; const bf16* G;
    __device__ void cols(int item, int& c0, int& c1) const { c0 = item; c1 = nhalf + item; }
    __device__ float f(int row, int c, float a) const {
        if (MODE == 1) return bf2f(G[(size_t)row * ldo + c]) * (a + bias[c]);
        if (MODE == 2) { const float r = a > 0.f ? a : 0.f; return r * r; }
        return a; }
    __device__ void store(int row, int item, float a0, float a1) const {
        O[(size_t)row * ldo + item] = (bf16)f2bf(f(row, item, a0)); O[(size_t)row * ldo + nhalf + item] = (bf16)f2bf(f(row, nhalf + item, a1)); }
};

__global__ void __launch_bounds__(256) nv_conv(const bf16* U, const float* cw, const float* cb, const float* lg, const float* lb, bf16* UC) {
    __shared__ float red[4];
    const int row = blockIdx.x, t = row % T, tid = threadIdx.x, c0 = tid * 4;
    float a[4];
#pragma unroll
    for (int j = 0; j < 4; ++j) a[j] = cb[c0 + j];
    for (int i = 0; i < CWID; ++i) { const int tt = t - (CWID - 1) + i; if (tt < 0) continue;
        const uint2 raw = *(const uint2*)(U + (size_t)(row - (CWID - 1) + i) * D + c0);
        const float4 w = *(const float4*)(cw + (size_t)i * D + c0);
        a[0] += __uint_as_float(raw.x << 16) * w.x; a[1] += __uint_as_float(raw.x & 0xffff0000u) * w.y;
        a[2] += __uint_as_float(raw.y << 16) * w.z; a[3] += __uint_as_float(raw.y & 0xffff0000u) * w.w; }
    const float mean = block_sum256((a[0] + a[1]) + (a[2] + a[3]), red) * (1.f / D);
    float q = 0.f;
#pragma unroll
    for (int j = 0; j < 4; ++j) { a[j] -= mean; q += a[j] * a[j]; }
    const float rstd = rsqrtf(block_sum256(q, red) * (1.f / D) + EPS);
    float o[4];
#pragma unroll
    for (int j = 0; j < 4; ++j) { const float y = a[j] * rstd * lg[c0 + j] + lb[c0 + j]; o[j] = y * sigmoidf_(y); }
    uint2 w; w.x = pk2(o[0], o[1]); w.y = pk2(o[2], o[3]);
    *(uint2*)(UC + (size_t)row * D + c0) = w;
}

__global__ void __launch_bounds__(128) nv_attn(const bf16* Q, const bf16* Kb, const bf16* V, bf16* O1, bf16* O2) {
    __shared__ float Ks[64][64]; __shared__ float Vs[64][64];
    const int tid = threadIdx.x, qb = blockIdx.x, vhd = blockIdx.y, b = blockIdx.z;
    const int s = vhd >> 4, h = (vhd >> 1) & 7, vh = vhd & 1, mh = s * 8 + h;
    const int qi = qb * 128 + tid; const size_t rowbase = (size_t)b * T;
    float q[64], o[64];
    { const bf16* qp = Q + (rowbase + qi) * D + mh * 64;
#pragma unroll
      for (int d = 0; d < 64; d += 2) { const unsigned w = *(const unsigned*)(qp + d); q[d] = __uint_as_float(w << 16); q[d + 1] = __uint_as_float(w & 0xffff0000u); } }
#pragma unroll
    for (int e = 0; e < 64; ++e) o[e] = 0.f;
    float m = -1e30f, l = 0.f;
    const int nt = (qb * 128 + 128) / 64;
    for (int kt = 0; kt < nt; ++kt) {
        __syncthreads();
        for (int i = tid; i < 64 * 32; i += 128) { const int r = i >> 5, c = (i & 31) * 2;
            const unsigned kw = *(const unsigned*)(Kb + (rowbase + kt * 64 + r) * D + mh * 64 + c);
            const unsigned vw = *(const unsigned*)(V + (rowbase + kt * 64 + r) * D + h * 128 + vh * 64 + c);
            Ks[r][c] = __uint_as_float(kw << 16); Ks[r][c + 1] = __uint_as_float(kw & 0xffff0000u);
            Vs[r][c] = __uint_as_float(vw << 16); Vs[r][c + 1] = __uint_as_float(vw & 0xffff0000u); }
        __syncthreads();
        for (int j = 0; j < 64; ++j) {
            if (kt * 64 + j > qi) break;
            float sdot = 0.f;
#pragma unroll
            for (int d = 0; d < 64; d += 4) { const float4 kv = *(const float4*)&Ks[j][d]; sdot += q[d] * kv.x + q[d + 1] * kv.y + q[d + 2] * kv.z + q[d + 3] * kv.w; }
            if (sdot > m) { const float f = exp2f(m - sdot); l *= f;
#pragma unroll
                for (int e = 0; e < 64; ++e) o[e] *= f;
                m = sdot; }
            const float p = exp2f(sdot - m); l += p;
#pragma unroll
            for (int e = 0; e < 64; e += 4) { const float4 vv = *(const float4*)&Vs[j][e]; o[e] += p * vv.x; o[e + 1] += p * vv.y; o[e + 2] += p * vv.z; o[e + 3] += p * vv.w; }
        }
    }
    const float rl = 1.f / l; bf16* op = (s ? O2 : O1) + (rowbase + qi) * D + h * 128 + vh * 64;
#pragma unroll
    for (int e = 0; e < 64; e += 2) *(unsigned*)(op + e) = pk2(o[e] * rl, o[e + 1] * rl);
}

__global__ void __launch_bounds__(256) nv_combine(const bf16* O1, const bf16* O2, const bf16* YC, const bf16* GA, const float* hn, const float* mod, bf16* Z) {
    const int row = blockIdx.x, tid = threadIdx.x, c0 = tid * 4; const float lam = mod[4 * 6144];
    const size_t off = (size_t)row * D + c0;
    const uint2 r1 = *(const uint2*)(O1 + off), r2 = *(const uint2*)(O2 + off), ry = *(const uint2*)(YC + off), rg = *(const uint2*)(GA + off);
    float a[4] = {__uint_as_float(r1.x << 16) - lam * __uint_as_float(r2.x << 16), __uint_as_float(r1.x & 0xffff0000u) - lam * __uint_as_float(r2.x & 0xffff0000u),
                  __uint_as_float(r1.y << 16) - lam * __uint_as_float(r2.y << 16), __uint_as_float(r1.y & 0xffff0000u) - lam * __uint_as_float(r2.y & 0xffff0000u)};
    float ss = (a[0] * a[0] + a[1] * a[1]) + (a[2] * a[2] + a[3] * a[3]);
#pragma unroll
    for (int o = 1; o < 32; o <<= 1) ss += __shfl_xor(ss, o);
    const float rstd = rsqrtf(ss * (1.f / VD) + EPS) * (1.f - LAM_INIT);
    const float yc[4] = {__uint_as_float(ry.x << 16), __uint_as_float(ry.x & 0xffff0000u), __uint_as_float(ry.y << 16), __uint_as_float(ry.y & 0xffff0000u)};
    const float ga[4] = {__uint_as_float(rg.x << 16), __uint_as_float(rg.x & 0xffff0000u), __uint_as_float(rg.y << 16), __uint_as_float(rg.y & 0xffff0000u)};
    float z[4];
#pragma unroll
    for (int j = 0; j < 4; ++j) z[j] = yc[j] + ga[j] * (a[j] * rstd * hn[(c0 + j) & 127]);
    uint2 w; w.x = pk2(z[0], z[1]); w.y = pk2(z[2], z[3]);
    *(uint2*)(Z + off) = w;
}

__global__ void __launch_bounds__(256) nv_x1(const float* x, const bf16* Y, const float* mod, const float* post1, const float* pre2, float* out, bf16* XN) {
    __shared__ float red[4];
    const int row = blockIdx.x, b = row / T, tid = threadIdx.x, c0 = tid * 4;
    const uint2 ry = *(const uint2*)(Y + (size_t)row * D + c0);
    const float y[4] = {__uint_as_float(ry.x << 16), __uint_as_float(ry.x & 0xffff0000u), __uint_as_float(ry.y << 16), __uint_as_float(ry.y & 0xffff0000u)};
    const float rstd = rsqrtf(block_sum256((y[0] * y[0] + y[1] * y[1]) + (y[2] * y[2] + y[3] * y[3]), red) * (1.f / D) + EPS);
    const float* mb = mod + b * 6144; const float4 xv = ((const float4*)(x + (size_t)row * D))[tid];
    const float xx[4] = {xv.x, xv.y, xv.z, xv.w}; float x1[4]; float ss = 0.f;
#pragma unroll
    for (int j = 0; j < 4; ++j) { x1[j] = xx[j] + mb[2048 + c0 + j] * (y[j] * rstd * post1[c0 + j]); ss += x1[j] * x1[j]; }
    ((float4*)(out + (size_t)row * D))[tid] = make_float4(x1[0], x1[1], x1[2], x1[3]);
    const float rstd2 = rsqrtf(block_sum256(ss, red) * (1.f / D) + EPS);
    float o[4];
#pragma unroll
    for (int j = 0; j < 4; ++j) o[j] = x1[j] * rstd2 * pre2[c0 + j] * (1.f + mb[4096 + c0 + j]) + mb[3072 + c0 + j];
    uint2 w; w.x = pk2(o[0], o[1]); w.y = pk2(o[2], o[3]);
    *(uint2*)(XN + (size_t)row * D + c0) = w;
}
__global__ void __launch_bounds__(256) nv_out(const bf16* F, const float* mod, const float* post2, float* out) {
    __shared__ float red[4];
    const int row = blockIdx.x, b = row / T, tid = threadIdx.x, c0 = tid * 4;
    const uint2 rf = *(const uint2*)(F + (size_t)row * D + c0);
    const float f[4] = {__uint_as_float(rf.x << 16), __uint_as_float(rf.x & 0xffff0000u), __uint_as_float(rf.y << 16), __uint_as_float(rf.y & 0xffff0000u)};
    const float rstd = rsqrtf(block_sum256((f[0] * f[0] + f[1] * f[1]) + (f[2] * f[2] + f[3] * f[3]), red) * (1.f / D) + EPS);
    const float* mb = mod + b * 6144; float4 xv = ((const float4*)(out + (size_t)row * D))[tid];
    xv.x += mb[5120 + c0 + 0] * (f[0] * rstd * post2[c0 + 0]); xv.y += mb[5120 + c0 + 1] * (f[1] * rstd * post2[c0 + 1]);
    xv.z += mb[5120 + c0 + 2] * (f[2] * rstd * post2[c0 + 2]); xv.w += mb[5120 + c0 + 3] * (f[3] * rstd * post2[c0 + 3]);
    ((float4*)(out + (size_t)row * D))[tid] = xv;
}


namespace pg8 {
#define PG8_LAS __attribute__((address_space(3)))
typedef unsigned short bf16_t;
typedef short bf16x8 __attribute__((ext_vector_type(8)));
typedef float f32x4 __attribute__((ext_vector_type(4)));
typedef unsigned u32x4 __attribute__((ext_vector_type(4)));
constexpr int BM = 256, BK = 64, HALF = 128, HTB = HALF * BK * 2  , STAGE_BYTES = 8 * HTB, NXCD = 8, WGM = 8;

__host__ __device__ __forceinline__ int lds_byte(int r, int c) { const int st = (r >> 4) * 2 + (c >> 5), rr = r & 15, cc = c & 31, ob = rr * 64 + cc * 2; return st * 1024 + (ob ^ (((ob >> 9) & 1) << 5)); }
__host__ __device__ __forceinline__ void stage_rc(int b, int& R, int& C) { const int st = b / 1024, sb = b % 1024, swz = sb ^ (((sb >> 9) & 1) << 5); R = (st >> 1) * 16 + swz / 64; C = (st & 1) * 32 + (swz % 64) / 2; }
__host__ __device__ __forceinline__ int perm32(int rho) { const int n = rho >> 4, i = rho & 15; return 8 * (i >> 2) + 4 * n + (i & 3); }

struct Unit { int pm, pn; };
struct Gemm { const bf16_t* A; const bf16_t* Bt; int M, N, K; };

struct StaticOrder {
    int nM, nN, nwg, G, c;
    __host__ __device__ void init(int M, int N, int G_, int c_) { nM = M / BM; nN = N / BM; nwg = nM * nN; G = G_; c = c_; }
    __host__ __device__ bool next(int i, Unit& u) const {
        const long L = (long)i * G + c; if (L >= nwg) return false;
        int wgid = (int)L; { const int q = nwg / NXCD, r = nwg % NXCD, xcd = wgid % NXCD, off = wgid / NXCD; wgid = (xcd < r ? xcd * (q + 1) : r * (q + 1) + (xcd - r) * q) + off; }
        const int nig = WGM * nN, gid = wgid / nig, fm = gid * WGM, gsz = (nM - fm) < WGM ? (nM - fm) : WGM;
        u.pm = fm + ((wgid % nig) % gsz); u.pn = (wgid % nig) / gsz; return true;
    }
    __device__ __forceinline__ void a_ready(const Unit&) const {}
    __device__ __forceinline__ void done(const Unit&) const {}
};

typedef float f32x2_cv __attribute__((ext_vector_type(2))); typedef __bf16 bf16x2_cv __attribute__((ext_vector_type(2)));
__device__ __forceinline__ unsigned cvt_pk_bf16(float lo, float hi) { f32x2_cv v = {lo, hi}; bf16x2_cv b = __builtin_convertvector(v, bf16x2_cv); return __builtin_bit_cast(unsigned, b); }
typedef float f32x2 __attribute__((ext_vector_type(2)));
template <class Epi, class Sched, bool ALIGN_EPI = false, bool SP2 = false>
__device__ __forceinline__ void gemm_phase(PG8_LAS unsigned char* lds, const Gemm g, const Sched& S, const Epi& E) {
    const int tid = threadIdx.x, wid = __builtin_amdgcn_readfirstlane(tid >> 6), lane = tid & 63, wr = wid >> 2, wc = wid & 3, fr = lane & 15, fq = lane >> 4;
    const int K = g.K, nt = K / BK;
    unsigned voffA[2], voffB[2];
#pragma unroll
    for (int i = 0; i < 2; ++i) { int R, C; stage_rc(tid * 16 + i * 8192, R, C); const int Rb = Epi::PERM ? ((R & ~31) + perm32(R & 31)) : R;
        voffA[i] = (unsigned)(R * K + C) * 2u; voffB[i] = (unsigned)(Rb * K + C) * 2u; }
    const size_t kstep = (size_t)(BK * 2);
    const size_t hstep = (size_t)HALF * K * 2;
    const size_t tstep = 2 * hstep;
    const unsigned ldsw = (unsigned)wid * 1024u;
    const int aoff = lds_byte(wr * 64 + fr, fq * 8), boff = lds_byte(wc * 32 + fr, fq * 8);
#define PG8_SA(b, h) (((b) * 2 + (h)) * HTB)
#define PG8_SB(b, h) ((4 + (b) * 2 + (h)) * HTB)
#define PG8_STAGE(bufoff, gbase, voff) do { _Pragma("unroll") for (int _i = 0; _i < 2; ++_i) \
        __builtin_amdgcn_global_load_lds((const unsigned*)((const char*)(gbase) + (voff)[_i]), (PG8_LAS unsigned*)(lds + (bufoff) + ldsw + _i * 8192), 16, 0, 0); } while (0)
#define PG8_LDA(dst, b, h) do { _Pragma("unroll") for (int m = 0; m < 4; ++m) _Pragma("unroll") for (int k = 0; k < 2; ++k) dst[m][k] = *(const PG8_LAS bf16x8*)(lds + PG8_SA(b, h) + aoff + m * 2048 + k * 1024); } while (0)
#define PG8_LDB(dst, b, h) do { _Pragma("unroll") for (int n = 0; n < 2; ++n) _Pragma("unroll") for (int k = 0; k < 2; ++k) dst[n][k] = *(const PG8_LAS bf16x8*)(lds + PG8_SB(b, h) + boff + n * 2048 + k * 1024); } while (0)
#define PG8_MMA(ai, bj, At, Bt) do { __builtin_amdgcn_s_setprio(1); _Pragma("unroll") for (int m = 0; m < 4; ++m) _Pragma("unroll") for (int n = 0; n < 2; ++n) _Pragma("unroll") for (int k = 0; k < 2; ++k) \
        acc[ai][bj][m][n] = __builtin_amdgcn_mfma_f32_16x16x32_bf16(Bt[n][k], At[m][k], acc[ai][bj][m][n], 0, 0, 0); __builtin_amdgcn_s_setprio(0); } while (0)
#define PG8_WAIT_V(n) asm volatile("s_waitcnt vmcnt(" #n ")" ::: "memory")
#define PG8_WAIT_L(n) asm volatile("s_waitcnt lgkmcnt(" #n ")" ::: "memory")
#define PG8_BAR __builtin_amdgcn_s_barrier()
#define PG8_SCHED __builtin_amdgcn_sched_barrier(0)
    Unit cur, nxt; int ui = 0;
    if (!S.next(0, cur)) return;
    f32x4 acc[2][2][4][2];
#pragma unroll
    for (int a = 0; a < 2; ++a)
#pragma unroll
        for (int b = 0; b < 2; ++b)
#pragma unroll
            for (int m = 0; m < 4; ++m)
#pragma unroll
                for (int n = 0; n < 2; ++n) acc[a][b][m][n] = (f32x4){0.f, 0.f, 0.f, 0.f};
    bf16x8 At[4][2], B0[2][2], B1[2][2];
    const char* cA = (const char*)g.A + (size_t)cur.pm * tstep; const char* cB = (const char*)g.Bt + (size_t)cur.pn * tstep;
    S.a_ready(cur);
    if constexpr (SP2) {
        PG8_STAGE(PG8_SB(0, 0), cB, voffB); PG8_STAGE(PG8_SB(0, 1), cB + hstep, voffB); PG8_STAGE(PG8_SA(0, 0), cA, voffA); PG8_STAGE(PG8_SA(0, 1), cA + hstep, voffA);
        if (wr == 1) PG8_BAR;
        PG8_WAIT_V(2); PG8_BAR;
        PG8_STAGE(PG8_SB(1, 0), cB + kstep, voffB); PG8_STAGE(PG8_SA(1, 0), cA + kstep, voffA); PG8_STAGE(PG8_SB(1, 1), cB + hstep + kstep, voffB);
        PG8_WAIT_V(6); PG8_BAR;
    } else {
        PG8_STAGE(PG8_SB(0, 0), cB, voffB); PG8_STAGE(PG8_SA(0, 0), cA, voffA); PG8_STAGE(PG8_SB(0, 1), cB + hstep, voffB); PG8_STAGE(PG8_SA(0, 1), cA + hstep, voffA);
        if (wr == 1) PG8_BAR;
        PG8_WAIT_V(4); PG8_BAR;
        PG8_STAGE(PG8_SB(1, 0), cB + kstep, voffB); PG8_STAGE(PG8_SA(1, 0), cA + kstep, voffA); PG8_STAGE(PG8_SB(1, 1), cB + hstep + kstep, voffB);
        PG8_WAIT_V(6); PG8_BAR;
    }
    for (;;) {
        const bool has_next = S.next(ui + 1, nxt);
        const char* nA = has_next ? (const char*)g.A + (size_t)nxt.pm * tstep : cA; const char* nB = has_next ? (const char*)g.Bt + (size_t)nxt.pn * tstep : cB;
        for (int t = 0; t < nt; t += 2) {
            const bool last = (t == nt - 2);
            const char* a1 = cA + (size_t)(t + 1) * kstep;
            const char* a2 = last ? nA : cA + (size_t)(t + 2) * kstep; const char* b2 = last ? nB : cB + (size_t)(t + 2) * kstep;
            const char* a3 = a2 + kstep; const char* b3 = b2 + kstep;
            if (last && has_next) S.a_ready(nxt);
            if constexpr (SP2) {
            PG8_LDB(B0, 0, 0); PG8_LDB(B1, 0, 1); PG8_SCHED; PG8_LDA(At, 0, 0); PG8_STAGE(PG8_SA(1, 1), a1 + hstep, voffA);
            PG8_WAIT_V(8); PG8_WAIT_L(0); PG8_BAR; PG8_MMA(0, 0, At, B0); PG8_MMA(0, 1, At, B1); PG8_BAR; PG8_SCHED;
            PG8_LDA(At, 0, 1); PG8_STAGE(PG8_SB(0, 0), b2, voffB); PG8_STAGE(PG8_SB(0, 1), b2 + hstep, voffB); PG8_STAGE(PG8_SA(0, 0), a2, voffA);
            PG8_WAIT_V(8); PG8_WAIT_L(0); PG8_BAR; PG8_MMA(1, 0, At, B0); PG8_MMA(1, 1, At, B1); PG8_BAR; PG8_SCHED;
            PG8_LDB(B0, 1, 0); PG8_LDB(B1, 1, 1); PG8_SCHED; PG8_LDA(At, 1, 0); PG8_STAGE(PG8_SA(0, 1), a2 + hstep, voffA);
            PG8_WAIT_V(8); PG8_WAIT_L(0); PG8_BAR; PG8_MMA(0, 0, At, B0); PG8_MMA(0, 1, At, B1); PG8_BAR; PG8_SCHED;
            PG8_LDA(At, 1, 1); PG8_STAGE(PG8_SB(1, 0), b3, voffB); PG8_STAGE(PG8_SB(1, 1), b3 + hstep, voffB); PG8_STAGE(PG8_SA(1, 0), a3, voffA);
            PG8_WAIT_V(8); PG8_WAIT_L(0); PG8_BAR; PG8_MMA(1, 0, At, B0); PG8_MMA(1, 1, At, B1); PG8_BAR; PG8_SCHED;
            } else {
            PG8_LDB(B0, 0, 0); PG8_SCHED; PG8_LDA(At, 0, 0); PG8_STAGE(PG8_SA(1, 1), a1 + hstep, voffA);
            PG8_WAIT_L(8); PG8_BAR; PG8_WAIT_L(0); PG8_MMA(0, 0, At, B0); PG8_BAR; PG8_SCHED;
            PG8_LDB(B1, 0, 1); PG8_STAGE(PG8_SB(0, 0), b2, voffB);
            PG8_BAR; PG8_WAIT_L(0); PG8_MMA(0, 1, At, B1); PG8_BAR;
            PG8_LDA(At, 0, 1); PG8_STAGE(PG8_SA(0, 0), a2, voffA);
            PG8_BAR; PG8_WAIT_L(0); PG8_MMA(1, 0, At, B0); PG8_BAR; PG8_SCHED;
            PG8_STAGE(PG8_SB(0, 1), b2 + hstep, voffB);
            PG8_WAIT_V(6); PG8_BAR; PG8_MMA(1, 1, At, B1); PG8_BAR;
            PG8_LDB(B0, 1, 0); PG8_SCHED; PG8_LDA(At, 1, 0); PG8_STAGE(PG8_SA(0, 1), a2 + hstep, voffA);
            PG8_WAIT_L(8); PG8_BAR; PG8_WAIT_L(0); PG8_MMA(0, 0, At, B0); PG8_BAR; PG8_SCHED;
            PG8_LDB(B1, 1, 1); PG8_STAGE(PG8_SB(1, 0), b3, voffB);
            PG8_BAR; PG8_WAIT_L(0); PG8_MMA(0, 1, At, B1); PG8_BAR;
            PG8_LDA(At, 1, 1); PG8_STAGE(PG8_SA(1, 0), a3, voffA);
            PG8_BAR; PG8_WAIT_L(0); PG8_MMA(1, 0, At, B0); PG8_BAR; PG8_SCHED;
            PG8_STAGE(PG8_SB(1, 1), b3 + hstep, voffB);
            PG8_WAIT_V(6); PG8_BAR; PG8_MMA(1, 1, At, B1); PG8_BAR;
            }
        }
        if constexpr (ALIGN_EPI) { if (wr == 0) PG8_BAR; }
        if constexpr (!Epi::AFTER_DRAIN) { E(acc, cur, wr, wc, fr, fq); S.done(cur); }
        if (!has_next) break;
#pragma unroll
        for (int a = 0; a < 2; ++a)
#pragma unroll
            for (int b = 0; b < 2; ++b)
#pragma unroll
                for (int m = 0; m < 4; ++m)
#pragma unroll
                    for (int n = 0; n < 2; ++n) acc[a][b][m][n] = (f32x4){0.f, 0.f, 0.f, 0.f};
        cur = nxt; cA = nA; cB = nB; ++ui;
        if constexpr (ALIGN_EPI) { if (wr == 1) PG8_BAR; }
    }
    PG8_WAIT_V(0);
    if constexpr (!ALIGN_EPI) { if (wr == 0) PG8_BAR; }
    PG8_BAR;
    if constexpr (Epi::AFTER_DRAIN) { E.fused(acc, cur, wr, wc, fr, fq, lds, wid, lane); S.done(cur); }
#undef PG8_SA
#undef PG8_SB
#undef PG8_STAGE
#undef PG8_LDA
#undef PG8_LDB
#undef PG8_MMA
#undef PG8_WAIT_V
#undef PG8_WAIT_L
#undef PG8_BAR
#undef PG8_SCHED
}
}

#ifndef PG8_SP2
#define PG8_SP2 true
#endif
#ifndef PG8_ALIGN
#define PG8_ALIGN true
#endif

#include <hip/hip_bf16.h>
#include <cmath>
namespace attn2 {
using bf16=__hip_bfloat16;
using bf16x8=__attribute__((ext_vector_type(8)))short;
using s16x4=__attribute__((ext_vector_type(4)))short;
using f32x16=__attribute__((ext_vector_type(16)))float;
using u32x4=__attribute__((ext_vector_type(4)))unsigned;
constexpr int SEQ=8192,D=64,DM=1024;
constexpr int NW=8,QBLK=32,QB=QBLK*NW,KVBLK=64,NQB=SEQ/QB;
constexpr int ATTN_PITCH=DM, ATTN_UNIT_ROWS=QB;
__device__ __forceinline__ int crow(int r,int hi){return (r&3)+8*(r>>2)+4*hi;}
#define SBAR() __builtin_amdgcn_sched_barrier(0)
__device__ __forceinline__ void cmask(f32x16&p0,f32x16&p1,int jb,int qrel,int hi){
  const float NEG=-INFINITY; int kb=64*jb+4*hi;
  #pragma unroll
  for(int r=0;r<16;++r){int kv=kb+(r&3)+8*(r>>2); if(kv>qrel)p0[r]=NEG; if(kv+32>qrel)p1[r]=NEG;}
}

constexpr int NSLOT=3, SLOTB=8192, VSLOTB=16384;
constexpr int LDS_K=0, LDS_V=NSLOT*SLOTB, LDS_WS=LDS_V+NSLOT*VSLOTB, LDS_OST=LDS_WS+NW*64*4, LDS_BYTES=LDS_OST+NW*4096;
constexpr float C2=0.125f*1.4426950408889634f;
__device__ __forceinline__ void glds16(const void*gsrc,unsigned lds_dst){unsigned keep;
  asm volatile("s_mov_b32 %0, m0\n\ts_mov_b32 m0, %2\n\ts_nop 0\n\tglobal_load_lds_dwordx4 %1, off\n\ts_mov_b32 m0, %0":"=&s"(keep):"v"(gsrc),"s"(lds_dst):"memory");}
__device__ __forceinline__ float max3f(float a,float b,float c){float r;asm("v_max3_f32 %0, %1, %2, %3":"=v"(r):"v"(a),"v"(b),"v"(c));return r;}
__device__ __forceinline__ float max2f(float a,float b){float r;asm("v_max_f32_e32 %0, %1, %2":"=v"(r):"v"(a),"v"(b));return r;}
__device__ __forceinline__ float fadd_s(float a,float b){float r;asm("v_add_f32_e32 %0, %1, %2":"=v"(r):"v"(a),"v"(b));return r;}
__device__ __forceinline__ float fsub_s(float a,float b){float r;asm("v_sub_f32_e32 %0, %1, %2":"=v"(r):"v"(a),"v"(b));return r;}
typedef float f32x2_t __attribute__((ext_vector_type(2))); typedef __bf16 bf16x2_t __attribute__((ext_vector_type(2)));
__device__ __forceinline__ unsigned cvtpk_s(float lo,float hi){f32x2_t v={lo,hi};bf16x2_t b=__builtin_convertvector(v,bf16x2_t);return __builtin_bit_cast(unsigned,b);}
#define WAIT_BAR(N) asm volatile("s_waitcnt vmcnt(" #N ") lgkmcnt(0)\n\ts_barrier":::"memory")

__device__ __forceinline__ void qkt(f32x16&p0,f32x16&p1,const char*Kslot,const bf16x8*qr,const f32x16&negm,int r32,int hi){
  const char*kb=Kslot+hi*1024+r32*16;
  #pragma unroll
  for(int d0=0;d0<4;++d0){
    const bf16x8 b0=*reinterpret_cast<const bf16x8*>(kb+d0*2048);
    const bf16x8 b1=*reinterpret_cast<const bf16x8*>(kb+d0*2048+512);
    if(d0==0){p0=__builtin_amdgcn_mfma_f32_32x32x16_bf16(b0,qr[0],negm,0,0,0);p1=__builtin_amdgcn_mfma_f32_32x32x16_bf16(b1,qr[0],negm,0,0,0);}
    else{p0=__builtin_amdgcn_mfma_f32_32x32x16_bf16(b0,qr[d0],p0,0,0,0);p1=__builtin_amdgcn_mfma_f32_32x32x16_bf16(b1,qr[d0],p1,0,0,0);}}
}
typedef __attribute__((address_space(3))) const char* lds_cptr;
typedef short v4i16_t __attribute__((ext_vector_type(4)));
__device__ __forceinline__ void kload8(bf16x8*kf,lds_cptr kp){
  kf[0]=*(const __attribute__((address_space(3))) bf16x8*)(kp);      kf[1]=*(const __attribute__((address_space(3))) bf16x8*)(kp+512);
  kf[2]=*(const __attribute__((address_space(3))) bf16x8*)(kp+2048); kf[3]=*(const __attribute__((address_space(3))) bf16x8*)(kp+2560);
  kf[4]=*(const __attribute__((address_space(3))) bf16x8*)(kp+4096); kf[5]=*(const __attribute__((address_space(3))) bf16x8*)(kp+4608);
  kf[6]=*(const __attribute__((address_space(3))) bf16x8*)(kp+6144); kf[7]=*(const __attribute__((address_space(3))) bf16x8*)(kp+6656);
}
__device__ __forceinline__ void kload2(bf16x8*kf,lds_cptr kp,int j){ kf[2*j]=*(const __attribute__((address_space(3))) bf16x8*)(kp+j*2048); kf[2*j+1]=*(const __attribute__((address_space(3))) bf16x8*)(kp+j*2048+512); }
__device__ __forceinline__ s16x4 vtr(lds_cptr p){ return __builtin_bit_cast(s16x4,__builtin_amdgcn_ds_read_tr16_b64_v4i16((__attribute__((address_space(3))) v4i16_t*)p)); }
__device__ __forceinline__ float rowmax(const f32x16&p0,const f32x16&p1){
  float a=max3f(p0[0],p0[1],p1[0]),b=max3f(p0[2],p0[3],p1[1]);a=max3f(a,p1[2],p1[3]);
  #pragma unroll
  for(int r=4;r<16;r+=4){a=max3f(a,p0[r],p0[r+1]);b=max3f(b,p0[r+2],p0[r+3]);a=max3f(a,p1[r],p1[r+1]);b=max3f(b,p1[r+2],p1[r+3]);}
  const float m=max2f(a,b);
  auto rr=__builtin_amdgcn_permlane32_swap(__float_as_uint(m),__float_as_uint(m),false,false);
  return max2f(__uint_as_float(rr[0]),__uint_as_float(rr[1]));
}
__device__ __forceinline__ void pv(f32x16*o,int vb,bf16x8 pa0,bf16x8 pa1,bf16x8 pa2,bf16x8 pa3){
  #pragma unroll
  for(int d0=0;d0<4;++d0){s16x4 lo[4],hi[4];
    #pragma unroll
    for(int ks=0;ks<4;++ks){
      asm volatile("ds_read_b64_tr_b16 %0,%1 offset:%c2":"=&v"(lo[ks]):"v"(vb),"i"(d0*4096+ks*1024):"memory");
      asm volatile("ds_read_b64_tr_b16 %0,%1 offset:%c2":"=&v"(hi[ks]):"v"(vb),"i"(d0*4096+ks*1024+512):"memory");}
    asm volatile("s_waitcnt lgkmcnt(0)":::"memory");SBAR();
    #define PK(k) (bf16x8){lo[k][0],lo[k][1],lo[k][2],lo[k][3],hi[k][0],hi[k][1],hi[k][2],hi[k][3]}
    o[d0]=__builtin_amdgcn_mfma_f32_32x32x16_bf16(pa0,PK(0),o[d0],0,0,0);
    o[d0]=__builtin_amdgcn_mfma_f32_32x32x16_bf16(pa1,PK(1),o[d0],0,0,0);
    o[d0]=__builtin_amdgcn_mfma_f32_32x32x16_bf16(pa2,PK(2),o[d0],0,0,0);
    o[d0]=__builtin_amdgcn_mfma_f32_32x32x16_bf16(pa3,PK(3),o[d0],0,0,0);
    #undef PK
  }
}

#ifndef ATTN_STORE16
#define ATTN_STORE16(p,v) (*(u32x4*)(p)=(v))
#endif
template<int THRL,class TT> __device__ __forceinline__ void attn_unit(long rowbase,int qkcol,int vcol,int qb,int smap,const bf16*Q,const bf16*__restrict__ K,const bf16*__restrict__ V,const TT&T,char*shm){
  const int tid=threadIdx.x,lane=tid&63,r32=lane&31,hi=lane>>5; const int wid=__builtin_amdgcn_readfirstlane(tid>>6);
  const int q0=qb*QB;
  const bf16*Qw=Q+(rowbase+q0+wid*QBLK)*DM+qkcol;
  const bf16*Kh=K+rowbase*DM+qkcol,*Vh=V+rowbase*DM+vcol;
  const unsigned lds0=(unsigned)(uintptr_t)shm;
  float*wsf=(float*)(shm+LDS_WS)+wid*64;
  const bf16*ksrc=Kh+(long)lane*DM+wid*8;
  const bf16*vsrc=Vh+(long)(16*(wid&3)+(lane>>2))*DM+(wid>>2)*32+(lane&3)*8;
  const unsigned kdst=lds0+LDS_K+wid*1024, vdst=lds0+LDS_V+wid*1024;
  #define DMA_K(t,slot) glds16(ksrc+(long)(t)*KVBLK*DM,(unsigned)__builtin_amdgcn_readfirstlane(kdst+(slot)))
  #define DMA_V(t,slot) do{ glds16(vsrc+(long)(t)*KVBLK*DM,(unsigned)__builtin_amdgcn_readfirstlane(vdst+2*(slot))); glds16(vsrc+64+(long)(t)*KVBLK*DM,(unsigned)__builtin_amdgcn_readfirstlane(vdst+2*(slot)+8192)); }while(0)
  const int vb0=(int)(lds0+LDS_V)+((lane>>4)&1)*32+(lane&3)*8+(4*hi+((lane&15)>>2))*64;
  const char*Kbase=shm+LDS_K; bf16x8 kf[8];
  const lds_cptr shm3=(lds_cptr)shm; const lds_cptr kp0=shm3+LDS_K+hi*1024+r32*16; const lds_cptr vp0=shm3+LDS_V+((lane>>4)&1)*32+(lane&3)*8+(4*hi+((lane&15)>>2))*64;
  const int NT=(q0+QB)/KVBLK;
  DMA_K(0,0);DMA_V(0,0);DMA_K(1,SLOTB);
  bf16x8 qr[4];
  #pragma unroll
  for(int d0=0;d0<4;++d0)qr[d0]=*reinterpret_cast<const bf16x8*>(&Qw[(long)r32*DM+d0*16+hi*8]);
  float mhat=0.f,l_reg=0.f;f32x16 o[4];o[0]=f32x16{};o[1]=f32x16{};o[2]=f32x16{};o[3]=f32x16{};f32x16 negm=f32x16{};asm volatile("":"+v"(negm));
  const int qrel=wid*QBLK+r32;
  #define CMASK(P0,P1,t) do{int jb_=(t)-(NT-4); if(jb_>=0)cmask(P0,P1,jb_,qrel,hi);}while(0)
  bool resc=false;
  #define START(P0,P1) do{ const float rm=rowmax(P0,P1); resc=false; \
    { const float dl=rm; mhat=fadd_s(mhat,dl); \
      _Pragma("unroll") for(int r=0;r<16;++r){P0[r]=fsub_s(P0[r],dl);P1[r]=fsub_s(P1[r],dl);} \
      _Pragma("unroll") for(int r=0;r<16;++r)negm[r]=-mhat; asm volatile("":"+v"(negm)); } \
    _Pragma("unroll") for(int r=0;r<16;++r)P0[r]=__builtin_amdgcn_exp2f(P0[r]); }while(0)
  #define RESC() do{ if(resc){ asm volatile("s_waitcnt lgkmcnt(0)":::"memory"); \
      _Pragma("unroll") for(int d_=0;d_<4;++d_) _Pragma("unroll") for(int r=0;r<16;++r)o[d_][r]*=wsf[crow(r,hi)]; } }while(0)
  f32x16 pA0,pA1,pB0,pB1;
  int sl_prev=0,sl_cur=0,sl_next=SLOTB;
  #define ROT() do{sl_prev=sl_cur;sl_cur=sl_next;sl_next=(sl_next==(NSLOT-1)*SLOTB)?0:sl_next+SLOTB;}while(0)
  DMA_K(2,2*SLOTB);
  WAIT_BAR(4);
  qkt(pA0,pA1,Kbase,qr,negm,r32,hi);asm volatile("s_nop 15\n\ts_nop 7":"+v"(pA0),"+v"(pA1));CMASK(pA0,pA1,0);
  START(pA0,pA1);
  _Pragma("unroll") for(int r=0;r<16;++r)pA1[r]=__builtin_amdgcn_exp2f(pA1[r]);
  WAIT_BAR(0);
  DMA_K(3,0);DMA_V(1,SLOTB);
  ROT();
  kload8(kf,kp0+sl_cur);
  WAIT_BAR(3);
  s16x4 vlo[16],vhi[16]; u32x4 pw0,pw1,pw2,pw3;
  #define PKW(P,B) cvtpk_s(P[B],P[B+1])
  #define PAF(k) __builtin_bit_cast(bf16x8,pw##k)
  #define VFR(i) (bf16x8){vlo[i][0],vlo[i][1],vlo[i][2],vlo[i][3],vhi[i][0],vhi[i][1],vhi[i][2],vhi[i][3]}
  #define PIN(x) asm volatile("":"+v"(x))
  #define MX3(a,b,c) __builtin_fmaxf(__builtin_fmaxf((a),(b)),(c))
  #define GAPA(MF,A0,A1,A2,A3,W0,W1,PW) do{ MF; sacc+=A0; sacc+=A1; sacc+=A2; sacc+=A3; PIN(sacc); W0; W1; PIN(PW); SBAR(); }while(0)
  #define EX(v) __builtin_amdgcn_exp2f(v)
  #define GAPB(MF,X,B) do{ MF; X[B]=EX(X[B]); X[B+1]=EX(X[B+1]); PIN(X); SBAR(); }while(0)
  #define VRD(i) do{ vlo[i]=vtr(vp_+(((i)&3)*4096+((i)>>2)*1024)); vhi[i]=vtr(vp_+(((i)&3)*4096+((i)>>2)*1024+512)); }while(0)
  #define KRD(G,j) do{ if(G){ kload2(kf,kp0+sl_next,j); SBAR(); } }while(0)
  #define STEP(C0,C1,P0,P1,t,GK,GV,GL) do{ SBAR(); \
    const lds_cptr vp_=vp0+2*sl_prev; \
    VRD(0); SBAR(); float sacc=(P0[0]+P0[1]); GAPA(C0=__builtin_amdgcn_mfma_f32_32x32x16_bf16(kf[0],qr[0],negm,0,0,0), P0[2],P0[3],P0[4],P0[5], pw0[0]=PKW(P0,0), pw0[1]=PKW(P0,2), pw0); \
    VRD(1); SBAR(); GAPA(C1=__builtin_amdgcn_mfma_f32_32x32x16_bf16(kf[1],qr[0],negm,0,0,0), P0[6],P0[7],P0[8],P0[9], pw0[2]=PKW(P0,4), pw0[3]=PKW(P0,6), pw0); \
    VRD(2); SBAR(); GAPA(C0=__builtin_amdgcn_mfma_f32_32x32x16_bf16(kf[2],qr[1],C0,0,0,0), P0[10],P0[11],P0[12],P0[13], pw1[0]=PKW(P0,8), pw1[1]=PKW(P0,10), pw1); \
    VRD(3); SBAR(); GAPA(C1=__builtin_amdgcn_mfma_f32_32x32x16_bf16(kf[3],qr[1],C1,0,0,0), P0[14],P0[15],P1[0],P1[1], pw1[2]=PKW(P0,12), pw1[3]=PKW(P0,14), pw1); \
    VRD(4); SBAR(); GAPA(C0=__builtin_amdgcn_mfma_f32_32x32x16_bf16(kf[4],qr[2],C0,0,0,0), P1[2],P1[3],P1[4],P1[5], pw2[0]=PKW(P1,0), pw2[1]=PKW(P1,2), pw2); \
    VRD(5); SBAR(); GAPA(C1=__builtin_amdgcn_mfma_f32_32x32x16_bf16(kf[5],qr[2],C1,0,0,0), P1[6],P1[7],P1[8],P1[9], pw2[2]=PKW(P1,4), pw2[3]=PKW(P1,6), pw2); \
    VRD(6); SBAR(); GAPA(C0=__builtin_amdgcn_mfma_f32_32x32x16_bf16(kf[6],qr[3],C0,0,0,0), P1[10],P1[11],P1[12],P1[13], pw3[0]=PKW(P1,8), pw3[1]=PKW(P1,10), pw3); \
    VRD(7); SBAR(); GAPA(C1=__builtin_amdgcn_mfma_f32_32x32x16_bf16(kf[7],qr[3],C1,0,0,0), P1[14],P1[15],0.f,0.f, pw3[2]=PKW(P1,12), pw3[3]=PKW(P1,14), pw3); \
    l_reg+=sacc; \
    if(GK){DMA_K((t)+3,sl_cur);} if(GV){DMA_V((t)+1,sl_next);} \
    CMASK(C0,C1,t); \
    { float a=MX3(C0[0],C0[1],C1[0]),b=MX3(C0[2],C0[3],C1[1]); a=MX3(a,C1[2],C1[3]); \
      _Pragma("unroll") for(int r=4;r<16;r+=4){a=MX3(a,C0[r],C0[r+1]);b=MX3(b,C0[r+2],C0[r+3]);a=MX3(a,C1[r],C1[r+1]);b=MX3(b,C1[r+2],C1[r+3]);} \
      float rm=__builtin_fmaxf(a,b); { auto rr=__builtin_amdgcn_permlane32_swap(__float_as_uint(rm),__float_as_uint(rm),false,false); rm=__builtin_fmaxf(__uint_as_float(rr[0]),__uint_as_float(rr[1])); } \
      resc=false; \
      if(__builtin_expect(__any(rm>(float)THRL),0)){ const float dl=__builtin_fmaxf(rm,0.f); mhat+=dl; \
        _Pragma("unroll") for(int r=0;r<16;++r){C0[r]-=dl;C1[r]-=dl;} \
        _Pragma("unroll") for(int r=0;r<16;++r)negm[r]=-mhat; asm volatile("":"+v"(negm)); \
        const float f=__builtin_amdgcn_exp2f(-dl); l_reg*=f; if(hi==0)wsf[r32]=f; resc=true; } } \
    SBAR(); \
    VRD(8); SBAR(); GAPB(o[0]=__builtin_amdgcn_mfma_f32_32x32x16_bf16(PAF(0),VFR(0),o[0],0,0,0), C0,0); \
    VRD(9); SBAR(); GAPB(o[1]=__builtin_amdgcn_mfma_f32_32x32x16_bf16(PAF(0),VFR(1),o[1],0,0,0), C0,2); \
    VRD(10); SBAR(); GAPB(o[2]=__builtin_amdgcn_mfma_f32_32x32x16_bf16(PAF(0),VFR(2),o[2],0,0,0), C0,4); \
    VRD(11); SBAR(); GAPB(o[3]=__builtin_amdgcn_mfma_f32_32x32x16_bf16(PAF(0),VFR(3),o[3],0,0,0), C0,6); \
    VRD(12); SBAR(); GAPB(o[0]=__builtin_amdgcn_mfma_f32_32x32x16_bf16(PAF(1),VFR(4),o[0],0,0,0), C0,8); \
    VRD(13); SBAR(); GAPB(o[1]=__builtin_amdgcn_mfma_f32_32x32x16_bf16(PAF(1),VFR(5),o[1],0,0,0), C0,10); \
    VRD(14); SBAR(); GAPB(o[2]=__builtin_amdgcn_mfma_f32_32x32x16_bf16(PAF(1),VFR(6),o[2],0,0,0), C0,12); \
    VRD(15); SBAR(); GAPB(o[3]=__builtin_amdgcn_mfma_f32_32x32x16_bf16(PAF(1),VFR(7),o[3],0,0,0), C0,14); \
    KRD(GL,0); GAPB(o[0]=__builtin_amdgcn_mfma_f32_32x32x16_bf16(PAF(2),VFR(8),o[0],0,0,0), C1,0); \
    KRD(GL,1); GAPB(o[1]=__builtin_amdgcn_mfma_f32_32x32x16_bf16(PAF(2),VFR(9),o[1],0,0,0), C1,2); \
    KRD(GL,2); GAPB(o[2]=__builtin_amdgcn_mfma_f32_32x32x16_bf16(PAF(2),VFR(10),o[2],0,0,0), C1,4); \
    KRD(GL,3); GAPB(o[3]=__builtin_amdgcn_mfma_f32_32x32x16_bf16(PAF(2),VFR(11),o[3],0,0,0), C1,6); \
    GAPB(o[0]=__builtin_amdgcn_mfma_f32_32x32x16_bf16(PAF(3),VFR(12),o[0],0,0,0), C1,8); \
    GAPB(o[1]=__builtin_amdgcn_mfma_f32_32x32x16_bf16(PAF(3),VFR(13),o[1],0,0,0), C1,10); \
    GAPB(o[2]=__builtin_amdgcn_mfma_f32_32x32x16_bf16(PAF(3),VFR(14),o[2],0,0,0), C1,12); \
    GAPB(o[3]=__builtin_amdgcn_mfma_f32_32x32x16_bf16(PAF(3),VFR(15),o[3],0,0,0), C1,14); \
    }while(0)
  int t=1;
  #undef CMASK
  #define CMASK(P0,P1,t) do{}while(0)
  for(;t+5<NT;t+=2){
    STEP(pB0,pB1,pA0,pA1,t,true,true,true);     WAIT_BAR(3); RESC(); ROT();
    STEP(pA0,pA1,pB0,pB1,t+1,true,true,true);   WAIT_BAR(3); RESC(); ROT();
  }
  #undef CMASK
  #define CMASK(P0,P1,t) do{int jb_=(t)-(NT-4); if(jb_>=0)cmask(P0,P1,jb_,qrel,hi);}while(0)
  #define ENDW(tt) do{ if((tt)+3<NT){WAIT_BAR(3);} else if((tt)+2<NT){WAIT_BAR(2);} else {WAIT_BAR(0);} }while(0)
  for(;t+1<NT;t+=2){
    STEP(pB0,pB1,pA0,pA1,t,(t+3<NT),(t+1<NT),(t+1<NT));       ENDW(t);   RESC(); ROT();
    STEP(pA0,pA1,pB0,pB1,t+1,(t+4<NT),(t+2<NT),(t+2<NT));     ENDW(t+1); RESC(); ROT();
  }
  STEP(pB0,pB1,pA0,pA1,NT-1,false,false,false); RESC();
  { float sacc=pB0[0]+pB0[1]; _Pragma("unroll") for(int r=2;r<16;++r)sacc+=pB0[r]; _Pragma("unroll") for(int r=0;r<16;++r)sacc+=pB1[r]; l_reg+=sacc;
    pw0=(u32x4){PKW(pB0,0),PKW(pB0,2),PKW(pB0,4),PKW(pB0,6)};pw1=(u32x4){PKW(pB0,8),PKW(pB0,10),PKW(pB0,12),PKW(pB0,14)};pw2=(u32x4){PKW(pB1,0),PKW(pB1,2),PKW(pB1,4),PKW(pB1,6)};pw3=(u32x4){PKW(pB1,8),PKW(pB1,10),PKW(pB1,12),PKW(pB1,14)};
    SBAR(); pv(o,vb0+2*sl_cur,PAF(0),PAF(1),PAF(2),PAF(3)); }
  #undef PKW
  #undef PAF
  #undef VFR
  #undef PIN
  #undef MX3
  #undef GAPA
  #undef GAPB
  #undef EX
  #undef VRD
  #undef KRD
  #undef STEP
  #undef ENDW
  {auto rr=__builtin_amdgcn_permlane32_swap(__float_as_uint(l_reg),__float_as_uint(l_reg),false,false);l_reg=__uint_as_float(rr[0])+__uint_as_float(rr[1]);}
  if(hi==0)wsf[32+r32]=l_reg;asm volatile("s_waitcnt lgkmcnt(0)":::"memory");
  float rli[16];
  #pragma unroll
  for(int r=0;r<16;++r)rli[r]=__builtin_amdgcn_rcpf(wsf[32+crow(r,hi)]);
  { typedef float f32x4_t __attribute__((ext_vector_type(4)));
    float* scrw=T.scr+((size_t)blockIdx.x*NW+wid)*4096+lane*4;
    if(smap==0){
      #pragma unroll
      for(int d0=0;d0<4;++d0)
        #pragma unroll
        for(int q4=0;q4<4;++q4){ const f32x4_t v={o[d0][4*q4]*rli[4*q4],o[d0][4*q4+1]*rli[4*q4+1],o[d0][4*q4+2]*rli[4*q4+2],o[d0][4*q4+3]*rli[4*q4+3]}; *(f32x4_t*)(scrw+(d0*4+q4)*256)=v; }
    } else {
      const float lam=__uint_as_float(__hip_atomic_load((const unsigned*)T.lam,__ATOMIC_RELAXED,__HIP_MEMORY_SCOPE_AGENT));
      #pragma unroll
      for(int d0=0;d0<4;++d0)
        #pragma unroll
        for(int q4=0;q4<4;++q4){ const f32x4_t v=*(const f32x4_t*)(scrw+(d0*4+q4)*256);
          #pragma unroll
          for(int e=0;e<4;++e)o[d0][4*q4+e]=v[e]-lam*(o[d0][4*q4+e]*rli[4*q4+e]); }
      bf16*stg=(bf16*)(shm+LDS_OST)+wid*2048;
      u32x4 av[2][4];
      #pragma unroll
      for(int hh=0;hh<2;++hh){
        #pragma unroll
        for(int r=0;r<16;++r){const int orow=crow(r,hi);
          #pragma unroll
          for(int d0=0;d0<2;++d0)stg[orow*64+d0*32+r32]=__float2bfloat16(o[2*hh+d0][r]);}
        asm volatile("s_waitcnt lgkmcnt(0)":::"memory");
        #pragma unroll
        for(int i=0;i<4;++i){const int row=i*8+(lane>>3),ch=lane&7; av[hh][i]=*(const u32x4*)(stg+row*64+ch*8);}
        asm volatile("s_waitcnt lgkmcnt(0)":::"memory"); }
      const int ch=lane&7;
      f32x4_t hn[2][2];
      #pragma unroll
      for(int hh=0;hh<2;++hh){ hn[hh][0]=*(const f32x4_t*)(T.hn+hh*64+ch*8)*0.8f; hn[hh][1]=*(const f32x4_t*)(T.hn+hh*64+ch*8+4)*0.8f; }
      #pragma unroll
      for(int i=0;i<4;++i){ float ss=0.f;
        #pragma unroll
        for(int hh=0;hh<2;++hh)
          #pragma unroll
          for(int w=0;w<4;++w){ const float lo_=__uint_as_float(av[hh][i][w]<<16),hi_=__uint_as_float(av[hh][i][w]&0xffff0000u); ss+=lo_*lo_+hi_*hi_; }
        ss+=__shfl_xor(ss,1); ss+=__shfl_xor(ss,2); ss+=__shfl_xor(ss,4);
        const float rstd=__builtin_amdgcn_rsqf(ss*(1.f/128.f)+1e-6f);
        const long off=(rowbase+q0+wid*QBLK+i*8+(lane>>3))*DM+vcol+ch*8;
        #pragma unroll
        for(int hh=0;hh<2;++hh){ const u32x4 yc=*(const u32x4*)(T.YC+off+hh*64), ga=*(const u32x4*)(T.GA+off+hh*64); u32x4 zz;
          #pragma unroll
          for(int w=0;w<4;++w){ const float a0=__uint_as_float(av[hh][i][w]<<16),a1=__uint_as_float(av[hh][i][w]&0xffff0000u);
            const float z0=__uint_as_float(yc[w]<<16)+__uint_as_float(ga[w]<<16)*(a0*rstd*hn[hh][w>>1][(w&1)*2]);
            const float z1=__uint_as_float(yc[w]&0xffff0000u)+__uint_as_float(ga[w]&0xffff0000u)*(a1*rstd*hn[hh][w>>1][(w&1)*2+1]);
            zz[w]=cvtpk_s(z0,z1); }
          ATTN_STORE16(T.Z+off+hh*64,zz); } }
    } }
  asm volatile("s_waitcnt lgkmcnt(0)\n\ts_barrier":::"memory");
  #undef DMA_K
  #undef DMA_V
  #undef CMASK
  #undef START
  #undef RESC
  #undef ROT
}
constexpr int ATTN_LDS_BYTES=LDS_BYTES;
#ifndef ATTN_REPS
#define ATTN_REPS 1
#endif
struct AttnTensors { const bf16* Q; const bf16* K; const bf16* V; const bf16* YC; const bf16* GA; bf16* Z; const float* hn; const float* lam; float* scr; };
struct AttnUnit { int b, mh, vo, s, qb; };
struct DealOrder {
  int vcu;
  __device__ __forceinline__ explicit DealOrder(int v):vcu(v){}
  __device__ __forceinline__ bool next(int i_,AttnUnit&u)const{ if(i_>=8*ATTN_REPS)return false; const int i=i_&7; const int bh=vcu>>3,h=bh&7,sub=vcu&7,s=i&1,k=i>>1,j=sub+8*(k>>1);
    u.b=bh>>3; u.mh=(s*8+h)*64; u.vo=h*128; u.s=s; u.qb=(k&1)?31-j:j; return true; }
};
template<class Sched,int THRL=8> __device__ __forceinline__ void attn_phase(char*lds,const AttnTensors&T,const Sched&S){
  AttnUnit u;
  for(int i=0;S.next(i,u);++i){ attn_unit<THRL,AttnTensors>((long)u.b*SEQ,u.mh,u.vo,u.qb,u.s,T.Q,T.K,T.V,T,lds); }
}
#undef SBAR
#undef WAIT_BAR
}


#define GAS __attribute__((address_space(1)))
#define LAS __attribute__((address_space(3)))
typedef unsigned v4u __attribute__((ext_vector_type(4)));
typedef float f32x4 __attribute__((ext_vector_type(4)));
typedef short bf16x8 __attribute__((ext_vector_type(8)));
typedef GAS unsigned gu32;
typedef GAS unsigned long long gu64;
#define RLX_AGENT __ATOMIC_RELAXED, __HIP_MEMORY_SCOPE_AGENT
#define LDS_WAIT() asm volatile("s_waitcnt lgkmcnt(0)" ::: "memory")
#define VM_WAIT() asm volatile("s_waitcnt vmcnt(0)" ::: "memory")
__device__ __forceinline__ unsigned long long rt() { return __builtin_amdgcn_s_memrealtime(); }

#define XB_TMO      128
#define XB_XCNT(j)  (256  + 64 * (j))
#define XB_XSUB(j)  (1280 + 64 * (j))
#define XB_XGEN(j)  (2304 + 64 * (j))
#define XB_TOP      3328
#define XB_TOPGEN   3392
#define XCD_BAR_WORDS 3456
#define XB_SPIN_CAP (1u << 18)

__device__ __forceinline__ unsigned xb_ld(unsigned* p)              { return __hip_atomic_load(p, __ATOMIC_RELAXED, __HIP_MEMORY_SCOPE_AGENT); }
__device__ __forceinline__ unsigned xb_add(unsigned* p, unsigned v) { return __hip_atomic_fetch_add(p, v, __ATOMIC_RELAXED, __HIP_MEMORY_SCOPE_AGENT); }
__device__ __forceinline__ unsigned xb_xcc_id() { return (unsigned)__builtin_amdgcn_s_getreg((3 << 11) | 20) & 0xFu; }
#define XB_SPIN(cond, bar) do { unsigned _sp = 0; while (cond) { __builtin_amdgcn_s_sleep(1); \
    if ((++_sp & 255u) == 0u) { if (xb_ld(&(bar)[XB_TMO])) break; if (_sp > XB_SPIN_CAP) { atomicAdd(&(bar)[XB_TMO], 1u); break; } } } } while (0)

struct XcdBarrier {
    unsigned* bar; unsigned x;
    volatile LAS unsigned* st;
};

__device__ __forceinline__ XcdBarrier xcd_barrier_post(unsigned* bar, volatile LAS unsigned* st) {
    XcdBarrier b; b.bar = bar; b.x = xb_xcc_id(); b.st = st;
    if (threadIdx.x == 0) (void)xb_add(&bar[XB_XCNT(b.x)], 1u);
    return b;
}
__device__ __forceinline__ void xcd_barrier_complete(unsigned* bar, unsigned x, unsigned& nloc, unsigned& nx) {
    const unsigned G = gridDim.x * gridDim.y * gridDim.z;
    unsigned sum, cnt, mine, sp = 0u;
    for (;;) {
        sum = 0u; cnt = 0u; mine = 0u;
#pragma unroll
        for (unsigned j = 0; j < 16; ++j) { const unsigned c = xb_ld(&bar[XB_XCNT(j)]); sum += c; cnt += (c > 0u) ? 1u : 0u; mine = (j == x) ? c : mine; }
        if (sum == G) break;
        __builtin_amdgcn_s_sleep(1);
        if ((++sp & 255u) == 0u) { if (xb_ld(&bar[XB_TMO])) break; if (sp > XB_SPIN_CAP) { atomicAdd(&bar[XB_TMO], 1u); break; } }
    }
    nloc = mine > 0u ? mine : 1u; nx = cnt > 0u ? cnt : 1u;
}

__device__ __forceinline__ void xcd_barrier(const XcdBarrier& b) {
    asm volatile("s_waitcnt vmcnt(0)" ::: "memory");
    __syncthreads();
    if (threadIdx.x == 0) {
        unsigned* bar = b.bar;
        __builtin_amdgcn_s_waitcnt(0);
        unsigned nloc = b.st[0], nx = b.st[1];
        if (nloc == 0u) { xcd_barrier_complete(bar, b.x, nloc, nx); b.st[0] = nloc; b.st[1] = nx; }
        const unsigned old = xb_add(&bar[XB_XSUB(b.x)], 1u);
        const unsigned gen = old / nloc;
        if (old + 1u == (gen + 1u) * nloc) {
            __builtin_amdgcn_fence(__ATOMIC_RELEASE, "agent");
            asm volatile("s_waitcnt vmcnt(0)" ::: "memory");
            const unsigned og = xb_add(&bar[XB_TOP], 1u);
            const unsigned tg = og / nx;
            if (og + 1u == (tg + 1u) * nx) xb_add(&bar[XB_TOPGEN], 1u);
            else XB_SPIN(xb_ld(&bar[XB_TOPGEN]) == tg, bar);
            __builtin_amdgcn_fence(__ATOMIC_ACQUIRE, "agent");
            xb_add(&bar[XB_XGEN(b.x)], 1u);
            asm volatile("s_waitcnt vmcnt(0)" ::: "memory");
        } else {
            XB_SPIN(xb_ld(&bar[XB_XGEN(b.x)]) == gen, bar);
            __builtin_amdgcn_fence(__ATOMIC_ACQUIRE, "agent");
            asm volatile("s_waitcnt vmcnt(0)" ::: "memory");
        }
    }
    __syncthreads();
}

namespace pg8 {
__device__ __forceinline__ float fast_sigmoid(float v) { return __builtin_amdgcn_rcpf(1.0f + __builtin_amdgcn_exp2f(-1.4426950408889634f * v)); }
__device__ __forceinline__ void st8(bf16_t* p, const f32x4& v0, const f32x4& v1) {
    u32x4 w; w.x = cvt_pk_bf16(v0[0], v0[1]); w.y = cvt_pk_bf16(v0[2], v0[3]); w.z = cvt_pk_bf16(v1[0], v1[1]); w.w = cvt_pk_bf16(v1[2], v1[3]); *(u32x4*)p = w; }
struct EpiProj {
    static constexpr bool PERM = true, AFTER_DRAIN = false;
    bf16_t *U, *Q, *Kb, *V, *GC, *GA; const float* rope;
    __device__ __forceinline__ void operator()(const f32x4 (&acc)[2][2][4][2], const Unit& u, int wr, int wc, int fr, int fq) const {
        const int row0 = u.pm * BM + wr * 64 + fr, pn = u.pn;
        if (pn < 8) {
            const int col = 128 * pn + 32 * wc + 8 * fq;
#pragma unroll
            for (int ai = 0; ai < 2; ++ai)
#pragma unroll
                for (int m = 0; m < 4; ++m) { f32x4 o[2];
#pragma unroll
                    for (int n = 0; n < 2; ++n)
#pragma unroll
                        for (int i = 0; i < 4; ++i) o[n][i] = acc[ai][0][m][n][i] * fast_sigmoid(acc[ai][1][m][n][i]);
                    st8(U + (size_t)(row0 + ai * HALF + m * 16) * 1024 + col, o[0], o[1]); }
        } else if (pn < 16) {
            const int qk = (pn - 8) >> 2, head = 4 * ((pn - 8) & 3) + wc, d0 = 8 * fq;
            bf16_t* P = qk ? Kb : Q; const float sc = qk ? 1.0f : 0.18033688011112042f;
#pragma unroll
            for (int ai = 0; ai < 2; ++ai)
#pragma unroll
                for (int m = 0; m < 4; ++m) { const int row = row0 + ai * HALF + m * 16; const float* rp = rope + ((size_t)(row & 8191) * 32 + d0) * 2;
                    f32x4 o1[2], o2[2];
#pragma unroll
                    for (int n = 0; n < 2; ++n) { const f32x4 cs0 = *(const f32x4*)(rp + 8 * n), cs1 = *(const f32x4*)(rp + 8 * n + 4);
                        const float cc[4] = {cs0[0], cs0[2], cs1[0], cs1[2]}, ss[4] = {cs0[1], cs0[3], cs1[1], cs1[3]};
#pragma unroll
                        for (int i = 0; i < 4; ++i) { const float x1 = acc[ai][0][m][n][i], x2 = acc[ai][1][m][n][i];
                            o1[n][i] = (x1 * cc[i] - x2 * ss[i]) * sc; o2[n][i] = (x2 * cc[i] + x1 * ss[i]) * sc; } }
                    bf16_t* rowp = P + (size_t)row * 1024 + head * 64 + d0; st8(rowp, o1[0], o1[1]); st8(rowp + 32, o2[0], o2[1]); }
        } else if (pn < 20) {
            const int col = 256 * (pn - 16) + 32 * wc + 8 * fq;
#pragma unroll
            for (int ai = 0; ai < 2; ++ai)
#pragma unroll
                for (int m = 0; m < 4; ++m)
#pragma unroll
                    for (int bj = 0; bj < 2; ++bj) st8(V + (size_t)(row0 + ai * HALF + m * 16) * 1024 + col + bj * HALF, acc[ai][bj][m][0], acc[ai][bj][m][1]);
        } else {
            bf16_t* P = (pn >= 24) ? GA : GC; const int col = 256 * ((pn - 20) & 3) + 32 * wc + 8 * fq;
#pragma unroll
            for (int ai = 0; ai < 2; ++ai)
#pragma unroll
                for (int m = 0; m < 4; ++m)
#pragma unroll
                    for (int bj = 0; bj < 2; ++bj) { f32x4 o[2];
#pragma unroll
                        for (int n = 0; n < 2; ++n)
#pragma unroll
                            for (int i = 0; i < 4; ++i) o[n][i] = fast_sigmoid(acc[ai][bj][m][n][i]);
                        st8(P + (size_t)(row0 + ai * HALF + m * 16) * 1024 + col + bj * HALF, o[0], o[1]); }
        }
    }
};
template <int MODE> struct EpiPlain {
    static constexpr bool PERM = true, AFTER_DRAIN = false;
    bf16_t* O; int ldc; const float* bias; const bf16_t* G;
    __device__ __forceinline__ void operator()(const f32x4 (&acc)[2][2][4][2], const Unit& u, int wr, int wc, int fr, int fq) const {
        const int row0 = u.pm * BM + wr * 64 + fr, col0 = u.pn * BM + wc * 32 + 8 * fq;
        f32x4 bv[2][2];
        if (MODE == 1) {
#pragma unroll
            for (int bj = 0; bj < 2; ++bj)
#pragma unroll
                for (int n = 0; n < 2; ++n) bv[bj][n] = *(const f32x4*)(bias + col0 + bj * HALF + 4 * n); }
#pragma unroll
        for (int ai = 0; ai < 2; ++ai)
#pragma unroll
            for (int m = 0; m < 4; ++m) { const size_t off = (size_t)(row0 + ai * HALF + m * 16) * ldc + col0;
#pragma unroll
                for (int bj = 0; bj < 2; ++bj) { f32x4 v0 = acc[ai][bj][m][0], v1 = acc[ai][bj][m][1];
                    if (MODE == 1) { const u32x4 g = *(const u32x4*)(G + off + bj * HALF);
                        v0 = v0 + bv[bj][0]; v1 = v1 + bv[bj][1];
                        v0[0] *= __uint_as_float(g.x << 16); v0[1] *= __uint_as_float(g.x & 0xffff0000u); v0[2] *= __uint_as_float(g.y << 16); v0[3] *= __uint_as_float(g.y & 0xffff0000u);
                        v1[0] *= __uint_as_float(g.z << 16); v1[1] *= __uint_as_float(g.z & 0xffff0000u); v1[2] *= __uint_as_float(g.w << 16); v1[3] *= __uint_as_float(g.w & 0xffff0000u); }
                    if (MODE == 2) {
#pragma unroll
                        for (int i = 0; i < 4; ++i) { const float a = __builtin_fmaxf(v0[i], 0.f), b = __builtin_fmaxf(v1[i], 0.f); v0[i] = a * a; v1[i] = b * b; } }
                    st8(O + off + bj * HALF, v0, v1); } }
    }
};
}

constexpr int NWAVES = 8;
typedef unsigned v2u __attribute__((ext_vector_type(2)));
constexpr size_t WS_WIN = 2 * MiB, WS_WC = 16 * MiB, WS_WO = 18 * MiB, WS_W1 = 20 * MiB, WS_W2 = 28 * MiB, WS_ROPET = 36 * MiB;
constexpr int CW_BAR = 4096;
constexpr size_t CTL_ZERO_BYTES = 1 * MiB;
constexpr int RING_OFF = 0, RING_BYTES = 131072;
constexpr int LDSCTL_OFF = RING_BYTES, MISC_OFF = LDSCTL_OFF + 320;
constexpr int LDS_BYTES = 147456;

struct Frame {
    LAS unsigned char* lds; volatile LAS unsigned* MISC;
    int tid, lane, wave, vcu, G;
};
__device__ __forceinline__ float wave_sum(float v) {
#pragma unroll
    for (int o = 1; o < 64; o <<= 1) v += __shfl_xor(v, o);
    return v;
}
__device__ __forceinline__ f32x4 bf4(unsigned lo, unsigned hi) { return (f32x4){__uint_as_float(lo << 16), __uint_as_float(lo & 0xffff0000u), __uint_as_float(hi << 16), __uint_as_float(hi & 0xffff0000u)}; }
__device__ __forceinline__ float gload_f32(const float* p) { return __uint_as_float(__hip_atomic_load((const unsigned*)p, __ATOMIC_RELAXED, __HIP_MEMORY_SCOPE_AGENT)); }

__device__ __forceinline__ int win_vrow(int n0) {
    if (n0 < 1024) return 256 * (n0 >> 7) + (n0 & 127);
    if (n0 < 2048) { const int n = n0 - 1024; return 256 * (n >> 7) + 128 + (n & 127); }
    if (n0 < 4096) { const int n = (n0 - 2048) & 1023, base = 2048 + ((n0 - 2048) & ~1023), head = n >> 6, half = (n >> 5) & 1; return base + 256 * (head >> 2) + 128 * half + 32 * (head & 3); }
    return n0;
}
template <bool PERMUTE> __device__ __forceinline__ void p0_transpose_item(const float* W, int K, int N, bf16* WT, LAS float* scr, int item, int lane) {
    const int nblk = N / 32, kb = item / nblk, nb = item % nblk, k0 = 64 * kb, n0 = 32 * nb;
    const int vr = PERMUTE ? win_vrow(n0) : n0;
#pragma unroll 8
    for (int i = 0; i < 32; ++i) { const int kk = 2 * i + (lane >> 5); scr[kk * 33 + (lane & 31)] = W[(size_t)(k0 + kk) * N + n0 + (lane & 31)]; }
    LDS_WAIT(); asm volatile("" ::: "memory");
    const int c = lane & 7;
#pragma unroll
    for (int j = 0; j < 4; ++j) { const int n = (lane >> 3) + 8 * j; const LAS float* s = scr + (8 * c) * 33 + n;
        v4u o; o.x = pk2(s[0 * 33], s[1 * 33]); o.y = pk2(s[2 * 33], s[3 * 33]); o.z = pk2(s[4 * 33], s[5 * 33]); o.w = pk2(s[6 * 33], s[7 * 33]);
        *(GAS v4u*)(WT + (size_t)(vr + n) * K + k0 + 8 * c) = o; }
    LDS_WAIT(); asm volatile("" ::: "memory");
}
__device__ __forceinline__ void sincos_d(double a, float& s, float& c) {
    const double k = __builtin_rint(a * 0.6366197723675814);
    double y = __builtin_fma(-k, 1.5707963267948966, a); y = __builtin_fma(-k, 6.123233995736766e-17, y);
    const double y2 = y * y;
    double sp = 1.0 / 6227020800.0; sp = sp * y2 - 1.0 / 39916800.0; sp = sp * y2 + 1.0 / 362880.0; sp = sp * y2 - 1.0 / 5040.0; sp = sp * y2 + 1.0 / 120.0; sp = sp * y2 - 1.0 / 6.0; sp = sp * y2 * y + y;
    double cp = 1.0 / 479001600.0; cp = cp * y2 - 1.0 / 3628800.0; cp = cp * y2 + 1.0 / 40320.0; cp = cp * y2 - 1.0 / 720.0; cp = cp * y2 + 1.0 / 24.0; cp = cp * y2 - 0.5; cp = cp * y2 + 1.0;
    const int q = ((int)k) & 3;
    const double sv = (q & 1) ? cp : sp, cv = (q & 1) ? sp : cp;
    s = (float)((q & 2) ? -sv : sv); c = (float)(((q + 1) & 2) ? -cv : cv);
}

struct Ptrs {
    const float *x, *c, *w_ada, *b_ada, *pre1, *post1, *w_in, *conv_w, *conv_b, *ln_g, *ln_b, *wc_out, *bc_out, *lq1, *lk1, *lq2, *lk2, *hn, *w_o, *pre2, *post2, *w1, *w2;
    float *out, *mod, *rope;
    bf16 *WIN, *WC, *WO, *W1, *W2, *R[7];
};

__device__ __forceinline__ void p0_prologue(Frame& F, const Ptrs& P) {
    {
        LAS float* red = (LAS float*)(F.lds + RING_OFF);
        const int j = F.tid & 31, kg = F.tid >> 5;
        for (int cb = F.vcu; cb < 256; cb += F.G) {
            const int col = cb * 24 + j; float a0 = 0.f, a1 = 0.f, a2 = 0.f, a3 = 0.f;
            if (j < 24) for (int k = kg * 64; k < kg * 64 + 64; ++k) { const float w = P.w_ada[(size_t)k * 6144 + col];
                const float c0 = P.c[k], c1 = P.c[1024 + k], c2 = P.c[2048 + k], c3 = P.c[3072 + k];
                a0 += c0 * sigmoidf_(c0) * w; a1 += c1 * sigmoidf_(c1) * w; a2 += c2 * sigmoidf_(c2) * w; a3 += c3 * sigmoidf_(c3) * w; }
            red[(kg * 4 + 0) * 32 + j] = a0; red[(kg * 4 + 1) * 32 + j] = a1; red[(kg * 4 + 2) * 32 + j] = a2; red[(kg * 4 + 3) * 32 + j] = a3;
            __syncthreads();
            if (F.tid < 128 && j < 24) { const int b = F.tid >> 5; float s = 0.f;
#pragma unroll
                for (int g = 0; g < 16; ++g) s += red[(g * 4 + b) * 32 + j];
                P.mod[b * 6144 + col] = s + P.b_ada[col]; }
            __syncthreads();
        }
        if (blockIdx.x == 0 && F.tid == 0) { float s1 = 0.f, s2 = 0.f;
            for (int i = 0; i < 64; ++i) { s1 += P.lq1[i] * P.lk1[i]; s2 += P.lq2[i] * P.lk2[i]; }
            P.mod[4 * 6144] = __expf(s1) - __expf(s2) + LAM_INIT; }
    }
    {
        const int gt = F.vcu * (NWAVES * 64) + F.tid, NT_ = F.G * NWAVES * 64;
        for (int e = gt; e < T * 32; e += NT_) { const int t = e >> 5, d = e & 31; double invf = 1.0;
            for (int i = 0; i < d; ++i) invf *= 0.7498942093324559;
            float s, c; sincos_d((double)t * invf, s, c); *(float2*)(P.rope + 2 * (size_t)e) = make_float2(c, s); }
    }
    {
        LAS float* scr = (LAS float*)(F.lds + RING_OFF + F.wave * 16384);
        const int gw = F.vcu * NWAVES + F.wave, NGW = F.G * NWAVES;
        constexpr int I_IN = (D / 64) * (DIN / 32), I_C = (D / 64) * (D / 32), I_O = I_C, I_1 = (D / 64) * (FF / 32), I_2 = (FF / 64) * (D / 32);
        constexpr int NITEMS = I_IN + I_C + I_O + I_1 + I_2;
        for (int it = gw; it < NITEMS; it += NGW) {
            int r = it;
            if (r < I_IN) { p0_transpose_item<true>(P.w_in, D, DIN, P.WIN, scr, r, F.lane); continue; } r -= I_IN;
            if (r < I_C) { p0_transpose_item<false>(P.wc_out, D, D, P.WC, scr, r, F.lane); continue; } r -= I_C;
            if (r < I_O) { p0_transpose_item<false>(P.w_o, D, D, P.WO, scr, r, F.lane); continue; } r -= I_O;
            if (r < I_1) { p0_transpose_item<false>(P.w1, D, FF, P.W1, scr, r, F.lane); continue; } r -= I_1;
            p0_transpose_item<false>(P.w2, FF, D, P.W2, scr, r, F.lane);
        }
    }
}
__device__ __forceinline__ void p1_h1(Frame& F, const Ptrs& P, bf16* XN) {
    const int gw = F.vcu * NWAVES + F.wave, NGW = F.G * NWAVES;
    for (int b = 0; b < BATCH; ++b) {
        const float* mb = P.mod + b * 6144; f32x4 A[4], Bv[4];
#pragma unroll
        for (int j = 0; j < 4; ++j) { const int c = 4 * F.lane + 256 * j; A[j] = *(const f32x4*)(P.pre1 + c) * (*(const f32x4*)(mb + 1024 + c) + 1.0f); Bv[j] = *(const f32x4*)(mb + c); }
        for (int r = gw; r < T; r += 2 * NGW) { f32x4 v[2][4]; float s[2];
#pragma unroll
            for (int u = 0; u < 2; ++u) { const size_t row = (size_t)b * T + r + u * NGW; const GAS f32x4* xr = (const GAS f32x4*)(P.x + row * D) + F.lane; s[u] = 0.f;
#pragma unroll
                for (int j = 0; j < 4; ++j) { v[u][j] = xr[64 * j]; s[u] += (v[u][j].x * v[u][j].x + v[u][j].y * v[u][j].y) + (v[u][j].z * v[u][j].z + v[u][j].w * v[u][j].w); } }
#pragma unroll
            for (int u = 0; u < 2; ++u) { const size_t row = (size_t)b * T + r + u * NGW; const float rstd = rsqrtf(wave_sum(s[u]) * (1.f / D) + EPS);
                GAS unsigned long long* o8 = (GAS unsigned long long*)(XN + row * D) + F.lane;
#pragma unroll
                for (int j = 0; j < 4; ++j) { const f32x4 o = v[u][j] * rstd * A[j] + Bv[j]; o8[64 * j] = (unsigned long long)pk2(o.x, o.y) | ((unsigned long long)pk2(o.z, o.w) << 32); } } }
    }
}
__device__ __forceinline__ void p3_conv(Frame& F, const Ptrs& P, const bf16* U, bf16* UC) {
    LAS unsigned char* lds = F.lds + RING_OFF;
    LAS float* P1 = (LAS float*)(lds + 62 * 2048); LAS float* P2 = P1 + 128;
    const int cq = F.wave & 3, th = F.wave >> 2, ch0 = cq * 256 + 4 * F.lane;
    const f32x4 cb = *(const f32x4*)(P.conv_b + ch0);
    for (int tile = F.vcu; tile < M / 32; tile += F.G) {
        const int row0 = tile * 32, t0 = row0 & (T - 1);
        for (int i = F.tid; i < 62 * 128; i += NWAVES * 64) { const int r = i >> 7, c16 = i & 127; v4u val = {0u, 0u, 0u, 0u};
            if (t0 - 30 + r >= 0) val = *(const GAS v4u*)(U + (size_t)(row0 - 30 + r) * D + c16 * 8);
            *(LAS v4u*)(lds + r * 2048 + c16 * 16) = val; }
        __syncthreads();
        f32x4 acc[16];
#pragma unroll
        for (int k = 0; k < 16; ++k) acc[k] = cb;
#pragma unroll 1
        for (int tb = 0; tb < 4; ++tb) {
            f32x4 w[8];
#pragma unroll
            for (int i = 0; i < 8; ++i) { const int tap = 8 * tb + i; w[i] = *(const f32x4*)(P.conv_w + (size_t)(tap < CWID ? tap : 0) * D + ch0); if (tap >= CWID) w[i] = (f32x4){0.f, 0.f, 0.f, 0.f}; }
            const LAS unsigned char* base = lds + (th * 16 + 8 * tb) * 2048 + ch0 * 2;
#pragma unroll
            for (int r = 0; r < 23; ++r) { v2u raw = *(const LAS v2u*)(base + r * 2048); if (r == 22 && tb == 3) raw = (v2u){0u, 0u};
                const f32x4 u = bf4(raw.x, raw.y);
#pragma unroll
                for (int k = 0; k < 16; ++k) { const int tl = r - k; if (tl >= 0 && tl < 8) acc[k] += u * w[tl]; } }
        }
#pragma unroll
        for (int k = 0; k < 16; ++k) { const float s = wave_sum((acc[k].x + acc[k].y) + (acc[k].z + acc[k].w)); if (F.lane == 0) P1[(th * 16 + k) * 4 + cq] = s; }
        __syncthreads();
#pragma unroll
        for (int k = 0; k < 16; ++k) { const f32x4 p = *(const LAS f32x4*)(P1 + (th * 16 + k) * 4); const float mean = ((p.x + p.y) + (p.z + p.w)) * (1.f / D);
            acc[k] = acc[k] - mean; const f32x4 a = acc[k]; const float q = wave_sum((a.x * a.x + a.y * a.y) + (a.z * a.z + a.w * a.w)); if (F.lane == 0) P2[(th * 16 + k) * 4 + cq] = q; }
        __syncthreads();
        const f32x4 lg = *(const f32x4*)(P.ln_g + ch0), lb = *(const f32x4*)(P.ln_b + ch0);
#pragma unroll
        for (int k = 0; k < 16; ++k) { const f32x4 p = *(const LAS f32x4*)(P2 + (th * 16 + k) * 4); const float rstd = rsqrtf(((p.x + p.y) + (p.z + p.w)) * (1.f / D) + EPS);
            f32x4 y = acc[k] * rstd * lg + lb;
#pragma unroll
            for (int i = 0; i < 4; ++i) y[i] = y[i] * pg8::fast_sigmoid(y[i]);
            *(GAS unsigned long long*)(UC + (size_t)(row0 + th * 16 + k) * D + ch0) = (unsigned long long)pk2(y.x, y.y) | ((unsigned long long)pk2(y.z, y.w) << 32); }
    }
    __syncthreads();
}
__device__ __forceinline__ void p6_combine(Frame& F, const Ptrs& P, const bf16* O1, const bf16* O2, const bf16* YC, const bf16* GA, bf16* Z) {
    const int gw = F.vcu * NWAVES + F.wave, NGW = F.G * NWAVES;
    const float lam = gload_f32(P.mod + 4 * 6144); const f32x4 hn4 = *(const f32x4*)(P.hn + 4 * (F.lane & 31)) * (1.f - LAM_INIT);
    for (int row = gw; row < M; row += NGW) { const size_t off = (size_t)row * D + 4 * F.lane;
#pragma unroll
        for (int j = 0; j < 4; ++j) { const v2u r1 = *(const GAS v2u*)(O1 + off + 256 * j), r2 = *(const GAS v2u*)(O2 + off + 256 * j), ry = *(const GAS v2u*)(YC + off + 256 * j), rg = *(const GAS v2u*)(GA + off + 256 * j);
            const f32x4 a = bf4(r1.x, r1.y) - bf4(r2.x, r2.y) * lam; float ss = (a.x * a.x + a.y * a.y) + (a.z * a.z + a.w * a.w);
#pragma unroll
            for (int o = 1; o < 32; o <<= 1) ss += __shfl_xor(ss, o);
            const float rstd = rsqrtf(ss * (1.f / VD) + EPS);
            const f32x4 z = bf4(ry.x, ry.y) + bf4(rg.x, rg.y) * (a * rstd * hn4);
            *(GAS unsigned long long*)(Z + off + 256 * j) = (unsigned long long)pk2(z.x, z.y) | ((unsigned long long)pk2(z.z, z.w) << 32); } }
}
__device__ __forceinline__ void p8_x1(Frame& F, const Ptrs& P, const bf16* Y, bf16* XN) {
    const int gw = F.vcu * NWAVES + F.wave, NGW = F.G * NWAVES;
    for (int b = 0; b < BATCH; ++b) {
        const float* mb = P.mod + b * 6144; f32x4 G1[4], A2[4], B2[4];
#pragma unroll
        for (int j = 0; j < 4; ++j) { const int c = 4 * F.lane + 256 * j; G1[j] = *(const f32x4*)(mb + 2048 + c) * *(const f32x4*)(P.post1 + c);
            A2[j] = *(const f32x4*)(P.pre2 + c) * (*(const f32x4*)(mb + 4096 + c) + 1.0f); B2[j] = *(const f32x4*)(mb + 3072 + c); }
        for (int r = gw; r < T; r += 2 * NGW) { f32x4 y[2][4], xv[2][4]; float s[2], s2[2];
#pragma unroll
            for (int u = 0; u < 2; ++u) { const size_t off = ((size_t)b * T + r + u * NGW) * D + 4 * F.lane; s[u] = 0.f;
#pragma unroll
                for (int j = 0; j < 4; ++j) { const v2u ry = *(const GAS v2u*)(Y + off + 256 * j); y[u][j] = bf4(ry.x, ry.y); xv[u][j] = *(const GAS f32x4*)(P.x + off + 256 * j);
                    s[u] += (y[u][j].x * y[u][j].x + y[u][j].y * y[u][j].y) + (y[u][j].z * y[u][j].z + y[u][j].w * y[u][j].w); } }
#pragma unroll
            for (int u = 0; u < 2; ++u) { const size_t off = ((size_t)b * T + r + u * NGW) * D + 4 * F.lane; const float rstd = rsqrtf(wave_sum(s[u]) * (1.f / D) + EPS); s2[u] = 0.f;
#pragma unroll
                for (int j = 0; j < 4; ++j) { xv[u][j] = xv[u][j] + G1[j] * (y[u][j] * rstd); *(GAS f32x4*)(P.out + off + 256 * j) = xv[u][j];
                    s2[u] += (xv[u][j].x * xv[u][j].x + xv[u][j].y * xv[u][j].y) + (xv[u][j].z * xv[u][j].z + xv[u][j].w * xv[u][j].w); } }
#pragma unroll
            for (int u = 0; u < 2; ++u) { const size_t off = ((size_t)b * T + r + u * NGW) * D + 4 * F.lane; const float rstd2 = rsqrtf(wave_sum(s2[u]) * (1.f / D) + EPS);
#pragma unroll
                for (int j = 0; j < 4; ++j) { const f32x4 o = xv[u][j] * rstd2 * A2[j] + B2[j];
                    *(GAS unsigned long long*)(XN + off + 256 * j) = (unsigned long long)pk2(o.x, o.y) | ((unsigned long long)pk2(o.z, o.w) << 32); } } }
    }
}
__device__ __forceinline__ void p11_out(Frame& F, const Ptrs& P, const bf16* Fb) {
    const int gw = F.vcu * NWAVES + F.wave, NGW = F.G * NWAVES;
    for (int b = 0; b < BATCH; ++b) {
        const float* mb = P.mod + b * 6144; f32x4 G2[4];
#pragma unroll
        for (int j = 0; j < 4; ++j) { const int c = 4 * F.lane + 256 * j; G2[j] = *(const f32x4*)(mb + 5120 + c) * *(const f32x4*)(P.post2 + c); }
        for (int r = gw; r < T; r += 2 * NGW) { f32x4 y[2][4], xv[2][4]; float s[2];
#pragma unroll
            for (int u = 0; u < 2; ++u) { const size_t off = ((size_t)b * T + r + u * NGW) * D + 4 * F.lane; s[u] = 0.f;
#pragma unroll
                for (int j = 0; j < 4; ++j) { const v2u ry = *(const GAS v2u*)(Fb + off + 256 * j); y[u][j] = bf4(ry.x, ry.y); xv[u][j] = *(const GAS f32x4*)(P.out + off + 256 * j);
                    s[u] += (y[u][j].x * y[u][j].x + y[u][j].y * y[u][j].y) + (y[u][j].z * y[u][j].z + y[u][j].w * y[u][j].w); } }
#pragma unroll
            for (int u = 0; u < 2; ++u) { const size_t off = ((size_t)b * T + r + u * NGW) * D + 4 * F.lane; const float rstd = rsqrtf(wave_sum(s[u]) * (1.f / D) + EPS);
#pragma unroll
                for (int j = 0; j < 4; ++j) *(GAS f32x4*)(P.out + off + 256 * j) = xv[u][j] + G2[j] * (y[u][j] * rstd); } }
    }
}

struct Args { const float* in[23]; float* out; unsigned char* ws; int ph_lo, ph_hi, li, pad; };
typedef const Args __attribute__((address_space(4))) CArgs;
__device__ __forceinline__ CArgs* kargs() { CArgs* p = (CArgs*)__builtin_amdgcn_kernarg_segment_ptr(); asm volatile("" : "+s"(p)); return p; }
__device__ __forceinline__ Ptrs make_ptrs(CArgs* A) {
    Ptrs P; unsigned char* ws = A->ws;
    P.x = A->in[0]; P.c = A->in[1]; P.w_ada = A->in[2]; P.b_ada = A->in[3]; P.pre1 = A->in[4]; P.post1 = A->in[5]; P.w_in = A->in[6]; P.conv_w = A->in[7];
    P.conv_b = A->in[8]; P.ln_g = A->in[9]; P.ln_b = A->in[10]; P.wc_out = A->in[11]; P.bc_out = A->in[12]; P.lq1 = A->in[13]; P.lk1 = A->in[14]; P.lq2 = A->in[15];
    P.lk2 = A->in[16]; P.hn = A->in[17]; P.w_o = A->in[18]; P.pre2 = A->in[19]; P.post2 = A->in[20]; P.w1 = A->in[21]; P.w2 = A->in[22];
    P.out = A->out; P.mod = (float*)(ws + WS_MOD); P.rope = (float*)(ws + WS_ROPET);
    P.WIN = (bf16*)(ws + WS_WIN); P.WC = (bf16*)(ws + WS_WC); P.WO = (bf16*)(ws + WS_WO); P.W1 = (bf16*)(ws + WS_W1); P.W2 = (bf16*)(ws + WS_W2);
#pragma unroll
    for (int i = 0; i < 7; ++i) P.R[i] = (bf16*)(ws + WS_R0 + (size_t)i * RSZ);
    return P;
}
#define PHASE_BEGIN() const Ptrs P = make_ptrs(kargs()); { int t_ = threadIdx.x; asm volatile("" : "+v"(t_)); F.tid = t_; F.lane = t_ & 63; } \
    bf16 *XN = P.R[0], *U = P.R[1], *Q = P.R[2], *Kb = P.R[3], *V = P.R[4], *GC = P.R[5], *GA = P.R[6]; \
    bf16 *UC = P.R[0], *YC = P.R[1], *O1 = P.R[0], *O2 = P.R[5], *Z = P.R[5], *Y = P.R[3], *F1 = P.R[1], *Fb = P.R[5]; \
    (void)XN; (void)U; (void)Q; (void)Kb; (void)V; (void)GC; (void)GA; (void)UC; (void)YC; (void)O1; (void)O2; (void)Z; (void)Y; (void)F1; (void)Fb;
__global__ void __launch_bounds__(NWAVES * 64, 2) mega_fwd(Args args) {
    extern __shared__ __attribute__((aligned(16))) unsigned char lds[];
    Frame F;
    F.lds = (LAS unsigned char*)lds;
    F.MISC = (volatile LAS unsigned*)(F.lds + MISC_OFF);
    F.tid = threadIdx.x; F.lane = F.tid & 63; F.wave = __builtin_amdgcn_readfirstlane(F.tid >> 6);
    F.G = gridDim.x; { const int bx = blockIdx.x; F.vcu = (F.G % 8 == 0) ? (bx % 8) * (F.G / 8) + bx / 8 : bx; }
    unsigned char* ws = args.ws;
    for (int u = F.tid; u < (LDS_BYTES - LDSCTL_OFF) / 4; u += NWAVES * 64) ((LAS unsigned*)(F.lds + LDSCTL_OFF))[u] = 0u;
    __syncthreads();
    XcdBarrier bar = xcd_barrier_post((unsigned*)(ws + WS_CTL) + CW_BAR + args.li * XCD_BAR_WORDS, F.MISC + 8);
    const int lo = args.ph_lo, hi = args.ph_hi;
#ifndef PHMASK
#define PHMASK 0xFFF
#endif
#define IN(k) ((((PHMASK) >> (k)) & 1) && lo <= (k) && (k) < hi)
#define SEAM(k) do { if (IN(k) && IN((k) + 1 + ((k) == 5))) xcd_barrier(bar); } while (0)
#ifndef DOUBLE_MASK
#define DOUBLE_MASK 0x000
#endif
#define REPS(k) _Pragma("unroll 1") for (int rep_ = 0; rep_ < ((((DOUBLE_MASK) >> (k)) & 1) ? 2 : 1); ++rep_)
    if (IN(0)) { PHASE_BEGIN(); p0_prologue(F, P); SEAM(0); }
    if (IN(1)) { PHASE_BEGIN(); REPS(1) p1_h1(F, P, XN); SEAM(1); }
    if (IN(2)) { PHASE_BEGIN();
        pg8::Gemm g{XN, P.WIN, M, DIN, D}; pg8::StaticOrder S; S.init(M, DIN, F.G, (int)blockIdx.x);
        pg8::EpiProj E{U, Q, Kb, V, GC, GA, P.rope};
        REPS(2) pg8::gemm_phase<pg8::EpiProj, pg8::StaticOrder, PG8_ALIGN, PG8_SP2>(F.lds + RING_OFF, g, S, E);
        SEAM(2); }
    if (IN(3)) { PHASE_BEGIN(); REPS(3) p3_conv(F, P, U, UC); SEAM(3); }
    if (IN(4)) { PHASE_BEGIN();
        pg8::Gemm g{UC, P.WC, M, D, D}; pg8::StaticOrder S; S.init(M, D, F.G, (int)blockIdx.x);
        pg8::EpiPlain<1> E{YC, D, P.bc_out, GC};
        pg8::gemm_phase<pg8::EpiPlain<1>, pg8::StaticOrder, PG8_ALIGN, PG8_SP2>(F.lds + RING_OFF, g, S, E);
        SEAM(4); }
    if (IN(5)) { PHASE_BEGIN();
        const attn2::AttnTensors AT{(const attn2::bf16*)Q, (const attn2::bf16*)Kb, (const attn2::bf16*)V, (const attn2::bf16*)YC, (const attn2::bf16*)GA, (attn2::bf16*)Z, P.hn, P.mod + 4 * 6144, (float*)P.R[0]};
        const attn2::DealOrder S(F.vcu);
        if (F.G == 256) attn2::attn_phase<attn2::DealOrder>((char*)lds + RING_OFF, AT, S);
        SEAM(5); }
    if (IN(7)) { PHASE_BEGIN();
        pg8::Gemm g{Z, P.WO, M, D, D}; pg8::StaticOrder S; S.init(M, D, F.G, (int)blockIdx.x);
        pg8::EpiPlain<0> E{Y, D, nullptr, nullptr};
        pg8::gemm_phase<pg8::EpiPlain<0>, pg8::StaticOrder, PG8_ALIGN, PG8_SP2>(F.lds + RING_OFF, g, S, E);
        SEAM(7); }
    if (IN(8)) { PHASE_BEGIN(); REPS(8) p8_x1(F, P, Y, XN); SEAM(8); }
    if (IN(9)) { PHASE_BEGIN();
        pg8::Gemm g{XN, P.W1, M, FF, D}; pg8::StaticOrder S; S.init(M, FF, F.G, (int)blockIdx.x);
        pg8::EpiPlain<2> E{F1, FF, nullptr, nullptr};
        pg8::gemm_phase<pg8::EpiPlain<2>, pg8::StaticOrder, PG8_ALIGN, PG8_SP2>(F.lds + RING_OFF, g, S, E);
        SEAM(9); }
    if (IN(10)) { PHASE_BEGIN();
        pg8::Gemm g{F1, P.W2, M, D, FF}; pg8::StaticOrder S; S.init(M, D, F.G, (int)blockIdx.x);
        pg8::EpiPlain<0> E{Fb, D, nullptr, nullptr};
        pg8::gemm_phase<pg8::EpiPlain<0>, pg8::StaticOrder, PG8_ALIGN, PG8_SP2>(F.lds + RING_OFF, g, S, E);
        SEAM(10); }
    if (IN(11)) { PHASE_BEGIN(); p11_out(F, P, Fb); }
#undef IN
#undef SEAM
}

#ifndef FASTMASK
#define PATCH_YN 16
#define FASTMASK 0xFFF
#endif
extern "C" void kernel_launch(void* const* d_in, const int* in_sizes, int n_in, void* d_out, int out_size, void* d_ws, size_t ws_size, hipStream_t stream) {
    static int grid = 0;
    if (grid == 0) {
        if (n_in != 23 || in_sizes[0] != M * D || out_size != M * D || ws_size < WS_END) { fprintf(stderr, "kernel_launch: unexpected shapes (n_in %d in0 %d out %d ws %zu)\n", n_in, n_in > 0 ? in_sizes[0] : -1, out_size, ws_size); grid = -1; return; }
        int dev = 0, cus = 0;
        if (hipGetDevice(&dev) != hipSuccess || hipDeviceGetAttribute(&cus, hipDeviceAttributeMultiprocessorCount, dev) != hipSuccess) { fprintf(stderr, "kernel_launch: device query failed\n"); grid = -1; return; }
        if (hipFuncSetAttribute((const void*)mega_fwd, hipFuncAttributeMaxDynamicSharedMemorySize, LDS_BYTES) != hipSuccess) { fprintf(stderr, "kernel_launch: hipFuncSetAttribute failed\n"); grid = -1; return; }
        (void)hipGetLastError();
        grid = cus;
        if (grid != 256) fprintf(stderr, "kernel_launch: %d CUs; the attention phase is dealt for 256\n", grid);
    }
    if (grid < 0) return;
    const float* x = (const float*)d_in[0]; const float* c = (const float*)d_in[1]; const float* w_ada = (const float*)d_in[2]; const float* b_ada = (const float*)d_in[3];
    const float* pre1 = (const float*)d_in[4]; const float* post1 = (const float*)d_in[5]; const float* w_in = (const float*)d_in[6]; const float* conv_w = (const float*)d_in[7];
    const float* conv_b = (const float*)d_in[8]; const float* ln_g = (const float*)d_in[9]; const float* ln_b = (const float*)d_in[10]; const float* wc_out = (const float*)d_in[11];
    const float* bc_out = (const float*)d_in[12]; const float* lq1 = (const float*)d_in[13]; const float* lk1 = (const float*)d_in[14]; const float* lq2 = (const float*)d_in[15];
    const float* lk2 = (const float*)d_in[16]; const float* hn = (const float*)d_in[17]; const float* w_o = (const float*)d_in[18]; const float* pre2 = (const float*)d_in[19];
    const float* post2 = (const float*)d_in[20]; const float* w1 = (const float*)d_in[21]; const float* w2 = (const float*)d_in[22];
    float* out = (float*)d_out; unsigned char* ws = (unsigned char*)d_ws;
    float* mod = (float*)(ws + WS_MOD);
    bf16* R[7]; for (int i = 0; i < 7; ++i) R[i] = (bf16*)(ws + WS_R0 + i * RSZ);
    bf16 *XN = R[0], *U = R[1], *Q = R[2], *Kb = R[3], *V = R[4], *GC = R[5], *GA = R[6];
    bf16 *UC = R[0], *YC = R[1], *O1 = R[0], *O2 = R[5], *Z = R[5], *Y = R[3], *F1 = R[1], *F = R[5];
    (void)hipMemsetAsync(ws + WS_CTL, 0, CTL_ZERO_BYTES, stream);
    Args a{};
    for (int i = 0; i < 23; ++i) a.in[i] = (const float*)d_in[i];
    a.out = out; a.ws = ws;
    int li = 0;
    auto mega = [&](int lo, int hi) { a.ph_lo = lo; a.ph_hi = hi; a.li = li++; hipLaunchKernelGGL(mega_fwd, dim3(grid), dim3(NWAVES * 64), LDS_BYTES, stream, a);
        const hipError_t le = hipPeekAtLastError(); if (le != hipSuccess) fprintf(stderr, "kernel_launch: launch [%d,%d) failed: %s\n", lo, hi, hipGetErrorName(le)); };
    const unsigned mask = FASTMASK;
#ifndef SPLIT_LAUNCHES
#define SPLIT_LAUNCHES 0
#endif
    if (mask == 0xFFFu && !SPLIT_LAUNCHES) { mega(0, 12); return; }
    if (mask == 0xFFFu) { for (int s = 0; s < 12; ++s) mega(s, s + 1); return; }
    auto naive = [&](int s) {
        switch (s) {
        case 0: nv_mod<<<dim3(6144 / 256, BATCH), 256, 0, stream>>>(c, w_ada, b_ada, lq1, lk1, lq2, lk2, mod); break;
        case 1: nv_h1<<<M, 256, 0, stream>>>(x, mod, pre1, XN); break;
        case 2: nv_gemm<NvProj><<<dim3(M / 64, 3584 / 64), 256, 0, stream>>>(XN, D, w_in, DIN, NvProj{U, Q, Kb, V, GC, GA}); break;
        case 3: nv_conv<<<M, 256, 0, stream>>>(U, conv_w, conv_b, ln_g, ln_b, UC); break;
        case 4: nv_gemm<NvPlain<1>><<<dim3(M / 64, 512 / 64), 256, 0, stream>>>(UC, D, wc_out, D, NvPlain<1>{YC, D, 512, bc_out, GC}); break;
        case 5: nv_attn<<<dim3(T / 128, 32, BATCH), 128, 0, stream>>>(Q, Kb, V, O1, O2); nv_combine<<<M, 256, 0, stream>>>(O1, O2, YC, GA, hn, mod, Z); break;
        case 6: break;
        case 7: nv_gemm<NvPlain<0>><<<dim3(M / 64, 512 / 64), 256, 0, stream>>>(Z, D, w_o, D, NvPlain<0>{Y, D, 512, nullptr, nullptr}); break;
        case 8: nv_x1<<<M, 256, 0, stream>>>(x, Y, mod, post1, pre2, out, XN); break;
        case 9: nv_gemm<NvPlain<2>><<<dim3(M / 64, 2048 / 64), 256, 0, stream>>>(XN, D, w1, FF, NvPlain<2>{F1, FF, 2048, nullptr, nullptr}); break;
        case 10: nv_gemm<NvPlain<0>><<<dim3(M / 64, 512 / 64), 256, 0, stream>>>(F1, FF, w2, D, NvPlain<0>{F, D, 512, nullptr, nullptr}); break;
        default: nv_out<<<M, 256, 0, stream>>>(F, mod, post2, out); break;
        } };
    const bool need_w = (mask & ((1u << 2) | (1u << 4) | (1u << 7) | (1u << 9) | (1u << 10))) != 0;
    int s = 0;
    if (!(mask & 1u)) { if (need_w) mega(0, 1); naive(0); s = 1; }
    while (s < 12) {
        if ((mask >> s) & 1u) { int e = s; while (e < 12 && ((mask >> e) & 1u)) ++e; mega(s, e);
#ifdef PATCH_Y0
            if (s <= 2 && e > 2) nv_gemm<NvProj><<<dim3(M / 64, PATCH_YN), 256, 0, stream>>>(XN, D, w_in, DIN, NvProj{U, Q, Kb, V, GC, GA}, PATCH_Y0);
#endif
            s = e; }
        else { naive(s); ++s; }
    }
}
```
